# Optimizing an MI355X kernel written in HIP

```python
import jax, jax.numpy as jnp
from jax import lax
import numpy as np

D_MODEL = 1024
BATCH = 1
SEQ = 16384
DEPTH = 2

RET_HEADS = 4
RET_QK_DIM = 128
RET_V_DIM = 256
RET_CHUNK = 128
ROPE_BASE = 10000.0
RET_Q = RET_HEADS * RET_QK_DIM
RET_V = RET_HEADS * RET_V_DIM
LRU_WIDTH = D_MODEL
LRU_BLOCKS = 8
LRU_BLOCK_DIM = LRU_WIDTH // LRU_BLOCKS
CONV_WIDTH = 4
LRU_C = 8.0
MEM_LEN = 256
XATTN_HEADS = 4
XATTN_HEAD_DIM = D_MODEL // XATTN_HEADS
PEER_HEADS = 8
PEER_KEYS = 128
PEER_EXPERTS = PEER_KEYS * PEER_KEYS
PEER_TOPK = 16
PEER_KEY_DIM = 256
PEER_HALF = PEER_KEY_DIM // 2
PEER_TOKEN_BLOCK = 128
EPS = 1e-6
IN_WIDTHS = (RET_Q, RET_Q, RET_V, RET_V, LRU_WIDTH, LRU_WIDTH, D_MODEL, D_MODEL)
IN_COLS = 2 * RET_Q + 2 * RET_V + 2 * LRU_WIDTH + 2 * D_MODEL

kernel_name = "hybrid_retention_rglru_peer_block"


def _rmsnorm(x, g):
    xf = x.astype(jnp.float32)
    y = xf * lax.rsqrt(jnp.mean(xf * xf, axis=-1, keepdims=True) + EPS) * g.astype(jnp.float32)
    return y.astype(x.dtype)


def _split_cols(z, widths):
    outs = []
    off = 0
    for w in widths:
        outs.append(z[..., off:off + w])
        off += w
    return outs


def _rotary(x, positions):
    d = x.shape[-1]
    inv_freq = ROPE_BASE ** (-jnp.arange(0, d, 2, dtype=jnp.float32) / d)
    ang = positions.astype(jnp.float32)[:, :, None] * inv_freq
    cos = jnp.cos(ang)[:, :, None, :]
    sin = jnp.sin(ang)[:, :, None, :]
    x1, x2 = x[..., : d // 2], x[..., d // 2:]
    return jnp.concatenate([x1 * cos - x2 * sin, x2 * cos + x1 * sin], axis=-1)


def _retention(q, k, v, positions):
    B, T, _ = q.shape
    H, dk, dv, C = RET_HEADS, RET_QK_DIM, RET_V_DIM, RET_CHUNK
    n = T // C
    q = _rotary(q.astype(jnp.float32).reshape(B, T, H, dk), positions)
    k = _rotary(k.astype(jnp.float32).reshape(B, T, H, dk), positions) * (dk ** -0.5)
    v = v.astype(jnp.float32).reshape(B, T, H, dv)
    log_g = jnp.log(1.0 - 2.0 ** (-5.0 - jnp.arange(H, dtype=jnp.float32)))
    qc = q.reshape(B, n, C, H, dk)
    kc = k.reshape(B, n, C, H, dk)
    vc = v.reshape(B, n, C, H, dv)
    i = jnp.arange(C, dtype=jnp.float32)
    diff = i[:, None] - i[None, :]
    decay = jnp.where(diff[None] >= 0, jnp.exp(diff[None] * log_g[:, None, None]), 0.0)
    scores = jnp.einsum('bnihd,bnjhd->bnhij', qc, kc) * decay
    inner = jnp.einsum('bnhij,bnjhe->bnihe', scores, vc)
    k_decay = jnp.exp((C - 1.0 - i)[:, None] * log_g[None, :])
    kv = jnp.einsum('bnjhd,bnjhe->nbhde', kc * k_decay[:, :, None], vc)
    chunk_decay = jnp.exp(C * log_g)[None, :, None, None]

    def step(state, kv_c):
        return chunk_decay * state + kv_c, state

    _, s_prev = lax.scan(step, jnp.zeros((B, H, dk, dv), jnp.float32), kv)
    q_decay = jnp.exp((i + 1.0)[:, None] * log_g[None, :])
    cross = jnp.einsum('bnihd,nbhde->bnihe', qc * q_decay[:, :, None], s_prev)
    o = (inner + cross).reshape(B, T, H, dv)
    mu = jnp.mean(o, axis=-1, keepdims=True)
    var = jnp.mean(jnp.square(o - mu), axis=-1, keepdims=True)
    o = (o - mu) * lax.rsqrt(var + EPS)
    return o.reshape(B, T, H * dv)


def _rg_lru_branch(x, positions, conv_w, conv_b, lru_wa, lru_ba, lru_wx, lru_bx, lru_lam):
    B, T, W = x.shape
    xf = x.astype(jnp.float32)
    xc = lax.conv_general_dilated(
        xf, conv_w.astype(jnp.float32)[:, None, :], window_strides=(1,),
        padding=[(CONV_WIDTH - 1, 0)], dimension_numbers=('NWC', 'WIO', 'NWC'),
        feature_group_count=W) + conv_b.astype(jnp.float32)
    xb = xc.reshape(B, T, LRU_BLOCKS, LRU_BLOCK_DIM)
    gate_r = jax.nn.sigmoid(jnp.einsum('btnc,ncd->btnd', xb, lru_wa.astype(jnp.float32))
                            + lru_ba.astype(jnp.float32)).reshape(B, T, W)
    gate_i = jax.nn.sigmoid(jnp.einsum('btnc,ncd->btnd', xb, lru_wx.astype(jnp.float32))
                            + lru_bx.astype(jnp.float32)).reshape(B, T, W)
    log_a = -LRU_C * gate_r * jax.nn.softplus(-lru_lam.astype(jnp.float32))
    a = jnp.exp(log_a)
    mult = jnp.sqrt(-jnp.expm1(2.0 * log_a))
    reset = (positions == 0)[:, :, None]
    a = jnp.where(reset, 0.0, a)
    mult = jnp.where(reset, 1.0, mult)
    b = xc * gate_i * mult

    def combine(c1, c2):
        a1, b1 = c1
        a2, b2 = c2
        return a1 * a2, a2 * b1 + b2

    _, h = lax.associative_scan(combine, (a, b), axis=1)
    return h


def _token_mixer(x, positions, g_mix, w_in, w_ret_br, w_rnn_br, w_mix_out,
                 conv_w, conv_b, lru_wa, lru_ba, lru_wx, lru_bx, lru_lam):
    h = _rmsnorm(x, g_mix)
    z = h @ w_in
    q, k, v, g_ret, x_rnn, y_rnn, gate_a, gate_b = _split_cols(z, IN_WIDTHS)
    ret = (jax.nn.silu(g_ret.astype(jnp.float32)) * _retention(q, k, v, positions)).astype(x.dtype)
    p_ret = ret @ w_ret_br
    rnn = _rg_lru_branch(x_rnn, positions, conv_w, conv_b, lru_wa, lru_ba, lru_wx, lru_bx, lru_lam)
    rnn = (rnn * jax.nn.gelu(y_rnn.astype(jnp.float32))).astype(x.dtype)
    p_rnn = rnn @ w_rnn_br
    merged = jax.nn.sigmoid(gate_a) * p_ret + jax.nn.sigmoid(gate_b) * p_rnn
    return merged @ w_mix_out


def _memory_cross_attention(x, mem, g_x, g_mem, w_xq, w_xk, w_xv, w_xo):
    B, T, D = x.shape
    M = mem.shape[1]
    h = _rmsnorm(x, g_x)
    m = _rmsnorm(mem, g_mem)
    q = (h @ w_xq).reshape(B, T, XATTN_HEADS, XATTN_HEAD_DIM)
    k = (m @ w_xk).reshape(B, M, XATTN_HEADS, XATTN_HEAD_DIM)
    v = (m @ w_xv).reshape(B, M, XATTN_HEADS, XATTN_HEAD_DIM)
    s = jnp.einsum('bthd,bmhd->bhtm', q, k).astype(jnp.float32) * (XATTN_HEAD_DIM ** -0.5)
    p = jax.nn.softmax(s, axis=-1).astype(v.dtype)
    o = jnp.einsum('bhtm,bmhd->bthd', p, v).reshape(B, T, D)
    return o @ w_xo


def _peer(x, g_ffn, w_pq, sub_k1, sub_k2, peer_u, peer_v):
    B, T, D = x.shape
    N = B * T
    K = PEER_TOPK
    hf = _rmsnorm(x, g_ffn).reshape(N, D)
    q = (hf @ w_pq).reshape(N, PEER_HEADS, PEER_KEY_DIM)
    q1, q2 = q[..., :PEER_HALF], q[..., PEER_HALF:]
    s1 = jnp.einsum('thd,hnd->thn', q1, sub_k1).astype(jnp.float32)
    s2 = jnp.einsum('thd,hnd->thn', q2, sub_k2).astype(jnp.float32)
    v1, i1 = lax.top_k(s1, K)
    v2, i2 = lax.top_k(s2, K)
    cand = (v1[..., :, None] + v2[..., None, :]).reshape(N, PEER_HEADS, K * K)
    vals, ci = lax.top_k(cand, K)
    e1 = jnp.take_along_axis(i1, ci // K, axis=-1)
    e2 = jnp.take_along_axis(i2, ci % K, axis=-1)
    idx = (e1 * PEER_KEYS + e2).reshape(N, PEER_HEADS * K)
    gates = jax.nn.softmax(vals, axis=-1).reshape(N, PEER_HEADS * K)
    nb = N // PEER_TOKEN_BLOCK

    def block(args):
        xb, ib, gb = args
        ub = jnp.take(peer_u, ib, axis=0)
        act = jax.nn.gelu(jnp.einsum('tkd,td->tk', ub, xb).astype(jnp.float32))
        vb = jnp.take(peer_v, ib, axis=0)
        return jnp.einsum('tk,tkd->td', (gb * act).astype(vb.dtype), vb)

    out = lax.map(block, (hf.reshape(nb, PEER_TOKEN_BLOCK, D),
                          idx.reshape(nb, PEER_TOKEN_BLOCK, PEER_HEADS * K),
                          gates.reshape(nb, PEER_TOKEN_BLOCK, PEER_HEADS * K)))
    return out.reshape(B, T, D)


def setup_inputs(seed: int = 0) -> dict:
    key = jax.random.key(seed)
    ks = jax.random.split(key, 32)
    f32 = jnp.float32
    L, D = DEPTH, D_MODEL

    def nrm(k, shape, fan_in):
        return jax.random.normal(k, shape, f32) * (fan_in ** -0.5)

    def gain(k, shape):
        return 1.0 + 0.02 * jax.random.normal(k, shape, f32)

    u = jax.random.uniform(ks[13], (L, LRU_WIDTH), f32, 0.9, 0.999)
    s = u ** (1.0 / LRU_C)
    lam = jnp.log(s) - jnp.log1p(-s)
    return {
        "x": jax.random.normal(ks[0], (BATCH, SEQ, D), f32),
        "mem": jax.random.normal(ks[1], (BATCH, MEM_LEN, D), f32),
        "positions": jnp.broadcast_to(jnp.arange(SEQ, dtype=jnp.int32)[None, :], (BATCH, SEQ)),
        "g_mix": gain(ks[2], (L, D)),
        "w_in": nrm(ks[3], (L, D, IN_COLS), D),
        "w_ret_br": nrm(ks[4], (L, RET_V, D), RET_V),
        "w_rnn_br": nrm(ks[5], (L, LRU_WIDTH, D), LRU_WIDTH),
        "w_mix_out": nrm(ks[6], (L, D, D), D),
        "conv_w": nrm(ks[7], (L, CONV_WIDTH, LRU_WIDTH), CONV_WIDTH),
        "conv_b": 0.01 * jax.random.normal(ks[8], (L, LRU_WIDTH), f32),
        "lru_wa": nrm(ks[9], (L, LRU_BLOCKS, LRU_BLOCK_DIM, LRU_BLOCK_DIM), LRU_BLOCK_DIM),
        "lru_ba": 0.01 * jax.random.normal(ks[10], (L, LRU_BLOCKS, LRU_BLOCK_DIM), f32),
        "lru_wx": nrm(ks[11], (L, LRU_BLOCKS, LRU_BLOCK_DIM, LRU_BLOCK_DIM), LRU_BLOCK_DIM),
        "lru_bx": 0.01 * jax.random.normal(ks[12], (L, LRU_BLOCKS, LRU_BLOCK_DIM), f32),
        "lru_lam": lam,
        "g_x": gain(ks[14], (L, D)),
        "g_mem": gain(ks[15], (L, D)),
        "w_xq": nrm(ks[16], (L, D, D), D),
        "w_xk": nrm(ks[17], (L, D, D), D),
        "w_xv": nrm(ks[18], (L, D, D), D),
        "w_xo": nrm(ks[19], (L, D, D), D),
        "g_ffn": gain(ks[20], (L, D)),
        "w_pq": nrm(ks[21], (L, D, PEER_HEADS * PEER_KEY_DIM), D),
        "sub_k1": nrm(ks[22], (L, PEER_HEADS, PEER_KEYS, PEER_HALF), PEER_HALF),
        "sub_k2": nrm(ks[23], (L, PEER_HEADS, PEER_KEYS, PEER_HALF), PEER_HALF),
        "peer_u": nrm(ks[24], (L, PEER_EXPERTS, D), D),
        "peer_v": nrm(ks[25], (L, PEER_EXPERTS, D), D),
        "g_final": gain(ks[26], (D,)),
    }


def reference(x, mem, positions, g_mix, w_in, w_ret_br, w_rnn_br, w_mix_out,
              conv_w, conv_b, lru_wa, lru_ba, lru_wx, lru_bx, lru_lam,
              g_x, g_mem, w_xq, w_xk, w_xv, w_xo,
              g_ffn, w_pq, sub_k1, sub_k2, peer_u, peer_v, g_final):
    for l in range(DEPTH):
        x = x + _token_mixer(x, positions, g_mix[l], w_in[l], w_ret_br[l], w_rnn_br[l], w_mix_out[l],
                             conv_w[l], conv_b[l], lru_wa[l], lru_ba[l], lru_wx[l], lru_bx[l], lru_lam[l])
        x = x + _memory_cross_attention(x, mem, g_x[l], g_mem[l], w_xq[l], w_xk[l], w_xv[l], w_xo[l])
        x = x + _peer(x, g_ffn[l], w_pq[l], sub_k1[l], sub_k2[l], peer_u[l], peer_v[l])
    return _rmsnorm(x, g_final)
```

```cpp
#include <hip/hip_runtime.h>
#include <cstdio>
#include <cstdint>
namespace pg8 {
#define PG8_LAS __attribute__((address_space(3)))
typedef unsigned short bf16_t;
typedef short bf16x8 __attribute__((ext_vector_type(8)));
typedef float f32x4 __attribute__((ext_vector_type(4)));
typedef unsigned u32x4 __attribute__((ext_vector_type(4)));
constexpr int BM = 256, BK = 64, HALF = 128, HTB = HALF * BK * 2  , STAGE_BYTES = 8 * HTB, NXCD = 8, WGM = 8;

__host__ __device__ __forceinline__ int lds_byte(int r, int c) { const int st = (r >> 4) * 2 + (c >> 5), rr = r & 15, cc = c & 31, ob = rr * 64 + cc * 2; return st * 1024 + (ob ^ (((ob >> 9) & 1) << 5)); }
__host__ __device__ __forceinline__ void stage_rc(int b, int& R, int& C) { const int st = b / 1024, sb = b % 1024, swz = sb ^ (((sb >> 9) & 1) << 5); R = (st >> 1) * 16 + swz / 64; C = (st & 1) * 32 + (swz % 64) / 2; }
__host__ __device__ __forceinline__ int perm32(int rho) { const int n = rho >> 4, i = rho & 15; return 8 * (i >> 2) + 4 * n + (i & 3); }

struct Unit { int pm, pn; };
struct Gemm { const bf16_t* A; const bf16_t* Bt; int M, N, K; };

struct StaticOrder {
    int nM, nN, nwg, G, c;
    __host__ __device__ void init(int M, int N, int G_, int c_) { nM = M / BM; nN = N / BM; nwg = nM * nN; G = G_; c = c_; }
    __host__ __device__ bool next(int i, Unit& u) const {
        const long L = (long)i * G + c; if (L >= nwg) return false;
        int wgid = (int)L; { const int q = nwg / NXCD, r = nwg % NXCD, xcd = wgid % NXCD, off = wgid / NXCD; wgid = (xcd < r ? xcd * (q + 1) : r * (q + 1) + (xcd - r) * q) + off; }
        const int nig = WGM * nN, gid = wgid / nig, fm = gid * WGM, gsz = (nM - fm) < WGM ? (nM - fm) : WGM;
        u.pm = fm + ((wgid % nig) % gsz); u.pn = (wgid % nig) / gsz; return true;
    }
    __device__ __forceinline__ void a_ready(const Unit&) const {}
    __device__ __forceinline__ void done(const Unit&) const {}
};

typedef float pg8_f2_t __attribute__((ext_vector_type(2)));
typedef __bf16 pg8_b2_t __attribute__((ext_vector_type(2)));
__device__ __forceinline__ unsigned cvt_pk_bf16(float lo, float hi) { const pg8_f2_t v = {lo, hi}; const pg8_b2_t r = __builtin_convertvector(v, pg8_b2_t); return __builtin_bit_cast(unsigned, r); }
typedef float f32x2 __attribute__((ext_vector_type(2)));
__device__ __forceinline__ f32x2 gelu_pk(f32x2 v) {
    const f32x2 av = __builtin_elementwise_abs(v), d = av * 0.2316418882f + 1.0f;
    f32x2 t; t.x = __builtin_amdgcn_rcpf(d.x); t.y = __builtin_amdgcn_rcpf(d.y);
    f32x2 q = t * 0.5307027145f + (-0.7265760135f); q = q * t + 0.7107068705f; q = q * t + (-0.142248368f); q = q * t + 0.127414796f; q = q * t;
    const f32x2 s = (v * v) * (-0.72134752044f);
    f32x2 e; e.x = __builtin_amdgcn_exp2f(s.x); e.y = __builtin_amdgcn_exp2f(s.y);
    const f32x2 m = v * (q * e), r = v - m;
    f32x2 o; o.x = v.x < 0.f ? m.x : r.x; o.y = v.y < 0.f ? m.y : r.y; return o;
}

template <int ACT  > struct EpiBf16 {
    static constexpr bool PERM = true, AFTER_DRAIN = false; static_assert(ACT == 0 || ACT == 1, "EpiBf16: ACT is 0 (none) or 1 (gelu_pk)");
    bf16_t* O; int ldc; const float* bias; int split_cols; size_t split_stride; float scale0; const unsigned long long* rowss;
    __device__ __forceinline__ void operator()(const f32x4 (&acc)[2][2][4][2], const Unit& u, int wr, int wc, int fr, int fq) const {
        const int row0 = u.pm * BM + wr * 64 + fr; int colt = u.pn * BM; bf16_t* base = O;
        float sc = 1.f; if (split_cols) { const int t = colt / split_cols; base += (size_t)t * split_stride; colt -= t * split_cols; if (t == 0) sc = scale0; }
        const int col0 = colt + wc * 32 + 8 * fq, bcol0 = u.pn * BM + wc * 32 + 8 * fq;
        f32x4 bv[2][2];
#pragma unroll
        for (int bj = 0; bj < 2; ++bj)
#pragma unroll
            for (int n = 0; n < 2; ++n) bv[bj][n] = bias ? *(const f32x4*)(bias + bcol0 + bj * HALF + 4 * n) : (f32x4){0.f, 0.f, 0.f, 0.f};
        unsigned long long rsv[2][4];
#pragma unroll
        for (int ai = 0; ai < 2; ++ai)
#pragma unroll
            for (int m = 0; m < 4; ++m) rsv[ai][m] = rowss ? rowss[row0 + ai * HALF + m * 16] : 0ull;
        asm volatile("" : "+v"(rsv[0][0]), "+v"(rsv[0][1]), "+v"(rsv[0][2]), "+v"(rsv[0][3]), "+v"(rsv[1][0]), "+v"(rsv[1][1]), "+v"(rsv[1][2]), "+v"(rsv[1][3]) :: "memory");
#pragma unroll
        for (int ai = 0; ai < 2; ++ai)
#pragma unroll
            for (int m = 0; m < 4; ++m) { bf16_t* rowp = base + (size_t)(row0 + ai * HALF + m * 16) * ldc + col0;
                const float rsc = rowss ? sc * __builtin_amdgcn_rsqf((float)rsv[ai][m] * (1.0f / 4294967296.0f / 1024.0f) + 1e-6f) : sc;
#pragma unroll
                for (int bj = 0; bj < 2; ++bj) { f32x4 v0 = acc[ai][bj][m][0] + bv[bj][0], v1 = acc[ai][bj][m][1] + bv[bj][1];
                    if (ACT == 1) { f32x2 a = gelu_pk((f32x2){v0[0], v0[1]}), b = gelu_pk((f32x2){v0[2], v0[3]}), c = gelu_pk((f32x2){v1[0], v1[1]}), d = gelu_pk((f32x2){v1[2], v1[3]});
                        v0 = (f32x4){a.x, a.y, b.x, b.y}; v1 = (f32x4){c.x, c.y, d.x, d.y}; }
                    v0 = v0 * rsc; v1 = v1 * rsc; u32x4 w; w.x = cvt_pk_bf16(v0[0], v0[1]); w.y = cvt_pk_bf16(v0[2], v0[3]); w.z = cvt_pk_bf16(v1[0], v1[1]); w.w = cvt_pk_bf16(v1[2], v1[3]);
                    *(u32x4*)(rowp + bj * HALF) = w; } }
    }
};
template <class Epi, class Sched, bool ALIGN_EPI = false, bool SP2 = false>
__device__ __forceinline__ void gemm_phase(PG8_LAS unsigned char* lds, const Gemm g, const Sched& S, const Epi& E) {
    int tid_l = threadIdx.x; asm volatile("" : "+v"(tid_l));
    const int tid = tid_l, wid = __builtin_amdgcn_readfirstlane(tid >> 6), lane = tid & 63, wr = wid >> 2, wc = wid & 3, fr = lane & 15, fq = lane >> 4;
    const int K = g.K, nt = K / BK;
    unsigned voffA[2], voffB[2];
#pragma unroll
    for (int i = 0; i < 2; ++i) { int R, C; stage_rc(tid * 16 + i * 8192, R, C); const int Rb = Epi::PERM ? ((R & ~31) + perm32(R & 31)) : R;
        voffA[i] = (unsigned)(R * K + C) * 2u; voffB[i] = (unsigned)(Rb * K + C) * 2u; }
    const size_t kstep = (size_t)(BK * 2);
    const size_t hstep = (size_t)HALF * K * 2;
    const size_t tstep = 2 * hstep;
    const unsigned ldsw = (unsigned)wid * 1024u;
    const int aoff = lds_byte(wr * 64 + fr, fq * 8), boff = lds_byte(wc * 32 + fr, fq * 8);
#define PG8_SA(b, h) (((b) * 2 + (h)) * HTB)
#define PG8_SB(b, h) ((4 + (b) * 2 + (h)) * HTB)
#define PG8_STAGE(bufoff, gbase, voff) do { _Pragma("unroll") for (int _i = 0; _i < 2; ++_i) \
        __builtin_amdgcn_global_load_lds((const unsigned*)((const char*)(gbase) + (voff)[_i]), (PG8_LAS unsigned*)(lds + (bufoff) + ldsw + _i * 8192), 16, 0, 0); } while (0)
#define PG8_LDA(dst, b, h) do { _Pragma("unroll") for (int m = 0; m < 4; ++m) _Pragma("unroll") for (int k = 0; k < 2; ++k) dst[m][k] = *(const PG8_LAS bf16x8*)(lds + PG8_SA(b, h) + aoff + m * 2048 + k * 1024); } while (0)
#define PG8_LDB(dst, b, h) do { _Pragma("unroll") for (int n = 0; n < 2; ++n) _Pragma("unroll") for (int k = 0; k < 2; ++k) dst[n][k] = *(const PG8_LAS bf16x8*)(lds + PG8_SB(b, h) + boff + n * 2048 + k * 1024); } while (0)
#define PG8_MMA(ai, bj, At, Bt) do { __builtin_amdgcn_s_setprio(1); _Pragma("unroll") for (int m = 0; m < 4; ++m) _Pragma("unroll") for (int n = 0; n < 2; ++n) _Pragma("unroll") for (int k = 0; k < 2; ++k) \
        acc[ai][bj][m][n] = __builtin_amdgcn_mfma_f32_16x16x32_bf16(Bt[n][k], At[m][k], acc[ai][bj][m][n], 0, 0, 0); __builtin_amdgcn_s_setprio(0); } while (0)
#define PG8_WAIT_V(n) asm volatile("s_waitcnt vmcnt(" #n ")" ::: "memory")
#define PG8_WAIT_L(n) asm volatile("s_waitcnt lgkmcnt(" #n ")" ::: "memory")
#define PG8_BAR __builtin_amdgcn_s_barrier()
#define PG8_SCHED __builtin_amdgcn_sched_barrier(0)
    Unit cur, nxt; int ui = 0;
    if (!S.next(0, cur)) return;
    f32x4 acc[2][2][4][2];
#pragma unroll
    for (int a = 0; a < 2; ++a)
#pragma unroll
        for (int b = 0; b < 2; ++b)
#pragma unroll
            for (int m = 0; m < 4; ++m)
#pragma unroll
                for (int n = 0; n < 2; ++n) acc[a][b][m][n] = (f32x4){0.f, 0.f, 0.f, 0.f};
    bf16x8 At[4][2], B0[2][2], B1[2][2];
    const char* cA = (const char*)g.A + (size_t)cur.pm * tstep; const char* cB = (const char*)g.Bt + (size_t)cur.pn * tstep;
    S.a_ready(cur);
    if constexpr (SP2) {
        PG8_STAGE(PG8_SB(0, 0), cB, voffB); PG8_STAGE(PG8_SB(0, 1), cB + hstep, voffB); PG8_STAGE(PG8_SA(0, 0), cA, voffA); PG8_STAGE(PG8_SA(0, 1), cA + hstep, voffA);
        if (wr == 1) PG8_BAR;
        PG8_WAIT_V(2); PG8_BAR;
        PG8_STAGE(PG8_SB(1, 0), cB + kstep, voffB); PG8_STAGE(PG8_SA(1, 0), cA + kstep, voffA); PG8_STAGE(PG8_SB(1, 1), cB + hstep + kstep, voffB);
        PG8_WAIT_V(6); PG8_BAR;
    } else {
        PG8_STAGE(PG8_SB(0, 0), cB, voffB); PG8_STAGE(PG8_SA(0, 0), cA, voffA); PG8_STAGE(PG8_SB(0, 1), cB + hstep, voffB); PG8_STAGE(PG8_SA(0, 1), cA + hstep, voffA);
        if (wr == 1) PG8_BAR;
        PG8_WAIT_V(4); PG8_BAR;
        PG8_STAGE(PG8_SB(1, 0), cB + kstep, voffB); PG8_STAGE(PG8_SA(1, 0), cA + kstep, voffA); PG8_STAGE(PG8_SB(1, 1), cB + hstep + kstep, voffB);
        PG8_WAIT_V(6); PG8_BAR;
    }
    for (;;) {
        const bool has_next = S.next(ui + 1, nxt);
        const char* nA = has_next ? (const char*)g.A + (size_t)nxt.pm * tstep : cA; const char* nB = has_next ? (const char*)g.Bt + (size_t)nxt.pn * tstep : cB;
        for (int t = 0; t < nt; t += 2) {
            const bool last = (t == nt - 2);
            const char* a1 = cA + (size_t)(t + 1) * kstep;
            const char* a2 = last ? nA : cA + (size_t)(t + 2) * kstep; const char* b2 = last ? nB : cB + (size_t)(t + 2) * kstep;
            const char* a3 = a2 + kstep; const char* b3 = b2 + kstep;
            if (last && has_next) S.a_ready(nxt);
            if constexpr (SP2) {
            PG8_LDB(B0, 0, 0); PG8_LDB(B1, 0, 1); PG8_SCHED; PG8_LDA(At, 0, 0); PG8_STAGE(PG8_SA(1, 1), a1 + hstep, voffA);
            PG8_WAIT_V(8); PG8_WAIT_L(0); PG8_BAR; PG8_MMA(0, 0, At, B0); PG8_MMA(0, 1, At, B1); PG8_BAR; PG8_SCHED;
            PG8_LDA(At, 0, 1); PG8_STAGE(PG8_SB(0, 0), b2, voffB); PG8_STAGE(PG8_SB(0, 1), b2 + hstep, voffB); PG8_STAGE(PG8_SA(0, 0), a2, voffA);
            PG8_WAIT_V(8); PG8_WAIT_L(0); PG8_BAR; PG8_MMA(1, 0, At, B0); PG8_MMA(1, 1, At, B1); PG8_BAR; PG8_SCHED;
            PG8_LDB(B0, 1, 0); PG8_LDB(B1, 1, 1); PG8_SCHED; PG8_LDA(At, 1, 0); PG8_STAGE(PG8_SA(0, 1), a2 + hstep, voffA);
            PG8_WAIT_V(8); PG8_WAIT_L(0); PG8_BAR; PG8_MMA(0, 0, At, B0); PG8_MMA(0, 1, At, B1); PG8_BAR; PG8_SCHED;
            PG8_LDA(At, 1, 1); PG8_STAGE(PG8_SB(1, 0), b3, voffB); PG8_STAGE(PG8_SB(1, 1), b3 + hstep, voffB); PG8_STAGE(PG8_SA(1, 0), a3, voffA);
            PG8_WAIT_V(8); PG8_WAIT_L(0); PG8_BAR; PG8_MMA(1, 0, At, B0); PG8_MMA(1, 1, At, B1); PG8_BAR; PG8_SCHED;
            } else {
            PG8_LDB(B0, 0, 0); PG8_SCHED; PG8_LDA(At, 0, 0); PG8_STAGE(PG8_SA(1, 1), a1 + hstep, voffA);
            PG8_WAIT_L(8); PG8_BAR; PG8_WAIT_L(0); PG8_MMA(0, 0, At, B0); PG8_BAR; PG8_SCHED;
            PG8_LDB(B1, 0, 1); PG8_STAGE(PG8_SB(0, 0), b2, voffB);
            PG8_BAR; PG8_WAIT_L(0); PG8_MMA(0, 1, At, B1); PG8_BAR;
            PG8_LDA(At, 0, 1); PG8_STAGE(PG8_SA(0, 0), a2, voffA);
            PG8_BAR; PG8_WAIT_L(0); PG8_MMA(1, 0, At, B0); PG8_BAR; PG8_SCHED;
            PG8_STAGE(PG8_SB(0, 1), b2 + hstep, voffB);
            PG8_WAIT_V(6); PG8_BAR; PG8_MMA(1, 1, At, B1); PG8_BAR;
            PG8_LDB(B0, 1, 0); PG8_SCHED; PG8_LDA(At, 1, 0); PG8_STAGE(PG8_SA(0, 1), a2 + hstep, voffA);
            PG8_WAIT_L(8); PG8_BAR; PG8_WAIT_L(0); PG8_MMA(0, 0, At, B0); PG8_BAR; PG8_SCHED;
            PG8_LDB(B1, 1, 1); PG8_STAGE(PG8_SB(1, 0), b3, voffB);
            PG8_BAR; PG8_WAIT_L(0); PG8_MMA(0, 1, At, B1); PG8_BAR;
            PG8_LDA(At, 1, 1); PG8_STAGE(PG8_SA(1, 0), a3, voffA);
            PG8_BAR; PG8_WAIT_L(0); PG8_MMA(1, 0, At, B0); PG8_BAR; PG8_SCHED;
            PG8_STAGE(PG8_SB(1, 1), b3 + hstep, voffB);
            PG8_WAIT_V(6); PG8_BAR; PG8_MMA(1, 1, At, B1); PG8_BAR;
            }
        }
        if constexpr (ALIGN_EPI) { if (wr == 0) PG8_BAR; }
        if constexpr (!Epi::AFTER_DRAIN) { E(acc, cur, wr, wc, fr, fq); S.done(cur); }
        if (!has_next) break;
#pragma unroll
        for (int a = 0; a < 2; ++a)
#pragma unroll
            for (int b = 0; b < 2; ++b)
#pragma unroll
                for (int m = 0; m < 4; ++m)
#pragma unroll
                    for (int n = 0; n < 2; ++n) acc[a][b][m][n] = (f32x4){0.f, 0.f, 0.f, 0.f};
        cur = nxt; cA = nA; cB = nB; ++ui;
        if constexpr (ALIGN_EPI) { if (wr == 1) PG8_BAR; }
    }
    PG8_WAIT_V(0);
    if constexpr (!ALIGN_EPI) { if (wr == 0) PG8_BAR; }
    PG8_BAR;
    if constexpr (Epi::AFTER_DRAIN) { E.fused(acc, cur, wr, wc, fr, fq, lds, wid, lane); S.done(cur); }
#undef PG8_SA
#undef PG8_SB
#undef PG8_STAGE
#undef PG8_LDA
#undef PG8_LDB
#undef PG8_MMA
#undef PG8_WAIT_V
#undef PG8_WAIT_L
#undef PG8_BAR
#undef PG8_SCHED
}
}

#ifndef PG8_SP2
#define PG8_SP2 true
#endif
#ifndef PG8_ALIGN
#define PG8_ALIGN true
#endif
namespace pg8 {
typedef unsigned u32x2 __attribute__((ext_vector_type(2)));
__device__ __forceinline__ float bflo(unsigned u) { return __builtin_bit_cast(float, u << 16); }
__device__ __forceinline__ float bfhi(unsigned u) { return __builtin_bit_cast(float, u & 0xffff0000u); }
__device__ __forceinline__ float sigm(float x) { return 1.0f / (1.0f + __expf(-x)); }
struct EpiGateF32 {
    static constexpr bool PERM = true, AFTER_DRAIN = false;
    bf16_t* O; const bf16_t* G; int ld;
    __device__ __forceinline__ void operator()(const f32x4 (&acc)[2][2][4][2], const Unit& u, int wr, int wc, int fr, int fq) const {
        const int row0 = u.pm * BM + wr * 64 + fr, col0 = u.pn * BM + wc * 32 + 8 * fq;
#pragma unroll
        for (int ai = 0; ai < 2; ++ai) {
            u32x4 gl[4][2];
#pragma unroll
            for (int m = 0; m < 4; ++m)
#pragma unroll
                for (int bj = 0; bj < 2; ++bj) gl[m][bj] = *(const u32x4*)(G + (size_t)(row0 + ai * HALF + m * 16) * ld + col0 + bj * HALF);
#pragma unroll
            for (int m = 0; m < 4; ++m)
#pragma unroll
                for (int bj = 0; bj < 2; ++bj) { const u32x4 gv = gl[m][bj];
                    f32x4 s0, s1; s0[0] = sigm(bflo(gv.x)); s0[1] = sigm(bfhi(gv.x)); s0[2] = sigm(bflo(gv.y)); s0[3] = sigm(bfhi(gv.y)); s1[0] = sigm(bflo(gv.z)); s1[1] = sigm(bfhi(gv.z)); s1[2] = sigm(bflo(gv.w)); s1[3] = sigm(bfhi(gv.w));
                    const f32x4 r0 = acc[ai][bj][m][0] * s0, r1 = acc[ai][bj][m][1] * s1;
                    u32x4 w; w.x = cvt_pk_bf16(r0[0], r0[1]); w.y = cvt_pk_bf16(r0[2], r0[3]); w.z = cvt_pk_bf16(r1[0], r1[1]); w.w = cvt_pk_bf16(r1[2], r1[3]);
                    *(u32x4*)(O + (size_t)(row0 + ai * HALF + m * 16) * ld + col0 + bj * HALF) = w; }
        }
    }
};
struct EpiMergeBf16 {
    static constexpr bool PERM = true, AFTER_DRAIN = false;
    const bf16_t* Tm; const bf16_t* G; bf16_t* O; int ld;
    __device__ __forceinline__ void operator()(const f32x4 (&acc)[2][2][4][2], const Unit& u, int wr, int wc, int fr, int fq) const {
        const int row0 = u.pm * BM + wr * 64 + fr, col0 = u.pn * BM + wc * 32 + 8 * fq;
#pragma unroll
        for (int ai = 0; ai < 2; ++ai) {
            u32x4 gl[4][2], tl[4][2];
#pragma unroll
            for (int m = 0; m < 4; ++m)
#pragma unroll
                for (int bj = 0; bj < 2; ++bj) { const size_t o = (size_t)(row0 + ai * HALF + m * 16) * ld + col0 + bj * HALF; gl[m][bj] = *(const u32x4*)(G + o); tl[m][bj] = *(const u32x4*)(Tm + o); }
#pragma unroll
            for (int m = 0; m < 4; ++m)
#pragma unroll
                for (int bj = 0; bj < 2; ++bj) { const u32x4 gv = gl[m][bj], tq = tl[m][bj];
                    f32x4 s0, s1; s0[0] = sigm(bflo(gv.x)); s0[1] = sigm(bfhi(gv.x)); s0[2] = sigm(bflo(gv.y)); s0[3] = sigm(bfhi(gv.y)); s1[0] = sigm(bflo(gv.z)); s1[1] = sigm(bfhi(gv.z)); s1[2] = sigm(bflo(gv.w)); s1[3] = sigm(bfhi(gv.w));
                    const f32x4 t0 = {bflo(tq.x), bfhi(tq.x), bflo(tq.y), bfhi(tq.y)}, t1 = {bflo(tq.z), bfhi(tq.z), bflo(tq.w), bfhi(tq.w)};
                    const f32x4 r0 = t0 + acc[ai][bj][m][0] * s0, r1 = t1 + acc[ai][bj][m][1] * s1;
                    u32x4 w; w.x = cvt_pk_bf16(r0[0], r0[1]); w.y = cvt_pk_bf16(r0[2], r0[3]); w.z = cvt_pk_bf16(r1[0], r1[1]); w.w = cvt_pk_bf16(r1[2], r1[3]);
                    *(u32x4*)(O + (size_t)(row0 + ai * HALF + m * 16) * ld + col0 + bj * HALF) = w; }
        }
    }
};
struct EpiResid16 {
    static constexpr bool PERM = true, AFTER_DRAIN = false;
    const float* Xin32; bf16_t* X16; unsigned long long* SS; int ld;
    __device__ __forceinline__ void operator()(const f32x4 (&acc)[2][2][4][2], const Unit& u, int wr, int wc, int fr, int fq) const {
        const int row0 = u.pm * BM + wr * 64 + fr, col0 = u.pn * BM + wc * 32 + 8 * fq;
#pragma unroll
        for (int ai = 0; ai < 2; ++ai) {
            u32x4 xb[4][2];
#pragma unroll
            for (int m = 0; m < 4; ++m)
#pragma unroll
                for (int bj = 0; bj < 2; ++bj) xb[m][bj] = *(const u32x4*)(X16 + (size_t)(row0 + ai * HALF + m * 16) * ld + col0 + bj * HALF);
#pragma unroll
            for (int m = 0; m < 4; ++m) { const int row = row0 + ai * HALF + m * 16; float ss = 0.f;
#pragma unroll
                for (int bj = 0; bj < 2; ++bj) { const u32x4 q = xb[m][bj];
                    const f32x4 x0 = (f32x4){bflo(q.x), bfhi(q.x), bflo(q.y), bfhi(q.y)} + acc[ai][bj][m][0], x1 = (f32x4){bflo(q.z), bfhi(q.z), bflo(q.w), bfhi(q.w)} + acc[ai][bj][m][1];
                    u32x4 w; w.x = cvt_pk_bf16(x0[0], x0[1]); w.y = cvt_pk_bf16(x0[2], x0[3]); w.z = cvt_pk_bf16(x1[0], x1[1]); w.w = cvt_pk_bf16(x1[2], x1[3]);
                    *(u32x4*)(X16 + (size_t)row * ld + col0 + bj * HALF) = w;
                    const float r0 = bflo(w.x), r1 = bfhi(w.x), r2 = bflo(w.y), r3 = bfhi(w.y), r4 = bflo(w.z), r5 = bfhi(w.z), r6 = bflo(w.w), r7 = bfhi(w.w);
                    ss += ((r0 * r0 + r1 * r1) + (r2 * r2 + r3 * r3)) + ((r4 * r4 + r5 * r5) + (r6 * r6 + r7 * r7)); }
                { const auto s16 = __builtin_amdgcn_permlane16_swap(__builtin_bit_cast(unsigned, ss), __builtin_bit_cast(unsigned, ss), false, false); const unsigned p0 = s16[0], p1 = s16[1]; ss = __builtin_bit_cast(float, p0) + __builtin_bit_cast(float, p1);
                  const auto s32 = __builtin_amdgcn_permlane32_swap(__builtin_bit_cast(unsigned, ss), __builtin_bit_cast(unsigned, ss), false, false); const unsigned q0 = s32[0], q1 = s32[1]; ss = __builtin_bit_cast(float, q0) + __builtin_bit_cast(float, q1); }
                if (fq == 0) atomicAdd(SS + row, (unsigned long long)(ss * 4294967296.0f)); }
        }
    }
};
}

constexpr int NWAVES = 8, NTHR = 512;
constexpr int T = 16384, D = 1024, NLAYER = 2, INC = 7168, PQC = 2048;
constexpr float EPS = 1e-6f;
constexpr size_t MiB = 1u << 20;
constexpr size_t WS_CTL = 0, CTL_ZERO_BYTES = 1 * MiB;
constexpr size_t WS_WIN = 2 * MiB, WS_WRET = 16 * MiB, WS_WRNN = 18 * MiB, WS_WMIX = 20 * MiB, WS_WXQ = 22 * MiB, WS_WXK = 24 * MiB, WS_WXV = 26 * MiB, WS_WXO = 28 * MiB, WS_WPQ = 30 * MiB;
constexpr size_t WS_LWA = 34 * MiB, WS_LWX = 34 * MiB + 256 * 1024, WS_SK1 = 34 * MiB + 512 * 1024, WS_SK2 = 34 * MiB + 768 * 1024;
constexpr size_t WS_MEMN = 35 * MiB, WS_KMEM = 35 * MiB + 512 * 1024, WS_VMEMT = 36 * MiB;
constexpr size_t WS_COS = 37 * MiB;
constexpr size_t WS_AGGA = 45 * MiB, WS_AGGB = 46 * MiB, WS_HIN = 47 * MiB;
typedef unsigned long long ss_t;
constexpr size_t WS_SS0 = 46 * MiB + 256 * 1024, WS_SSA = 46 * MiB + 384 * 1024, WS_SSB = 46 * MiB + 512 * 1024, WS_SSC = 46 * MiB + 640 * 1024;
constexpr size_t WS_SSA_DOC = 0;
constexpr size_t WS_PU8 = 48 * MiB, WS_PV8 = 64 * MiB, WS_SCU = 45 * MiB + 768 * 1024, WS_SCV = 45 * MiB + 832 * 1024;
constexpr size_t WS_LB = 80 * MiB;
constexpr size_t WS_XN = 112 * MiB;
constexpr size_t WS_LA = 400 * MiB;
constexpr size_t WS_Z = 144 * MiB, ZSTRIDE = 32 * MiB;
constexpr size_t WS_KV = 368 * MiB, WS_END = 432 * MiB;
constexpr size_t WS_TMP = WS_Z;
constexpr size_t WS_MERGED = WS_Z + 3 * ZSTRIDE;
constexpr size_t WS_QX = WS_Z + 3 * ZSTRIDE;
constexpr size_t WS_PQ = WS_Z + 2 * ZSTRIDE;
constexpr size_t WS_IDX = WS_KV, WS_GATE = WS_KV + 8 * MiB;
constexpr size_t WS_SRAW = WS_Z + 5 * ZSTRIDE;
constexpr size_t WS_PW = WS_Z;
constexpr size_t SLICE_BYTES = (size_t)16384 * 128;
constexpr int CW_BAR = 4096;
constexpr int LDS_BYTES = 163840;
constexpr int LDSCTL_OFF = 163840 - 512, MISC_OFF = LDSCTL_OFF;

#define GAS __attribute__((address_space(1)))
#define LAS __attribute__((address_space(3)))
typedef unsigned short bf16;
#define KEEP2(a, b) asm volatile("" : "+v"(a), "+v"(b) :: "memory")
#define KEEP4(a, b, c, d) asm volatile("" : "+v"(a), "+v"(b), "+v"(c), "+v"(d) :: "memory")
#define KEEP6(a, b, c, d, e, f) asm volatile("" : "+v"(a), "+v"(b), "+v"(c), "+v"(d), "+v"(e), "+v"(f) :: "memory")
#define KEEP8(x) asm volatile("" : "+v"((x)[0]), "+v"((x)[1]), "+v"((x)[2]), "+v"((x)[3]), "+v"((x)[4]), "+v"((x)[5]), "+v"((x)[6]), "+v"((x)[7]) :: "memory")
typedef unsigned v4u __attribute__((ext_vector_type(4)));
typedef unsigned v2u __attribute__((ext_vector_type(2)));
typedef float f32x4 __attribute__((ext_vector_type(4)));
typedef short bf16x8 __attribute__((ext_vector_type(8)));
typedef short s16x4 __attribute__((ext_vector_type(4)));
typedef __bf16 bf16x2_t __attribute__((ext_vector_type(2)));
typedef GAS unsigned gu32;
#define RLX_AGENT __ATOMIC_RELAXED, __HIP_MEMORY_SCOPE_AGENT
#define LDS_WAIT() asm volatile("s_waitcnt lgkmcnt(0)" ::: "memory")
typedef float cvf2_t __attribute__((ext_vector_type(2)));
typedef __bf16 cvb2_t __attribute__((ext_vector_type(2)));
__device__ __forceinline__ unsigned cvt_pk_nv(float lo, float hi) { const cvf2_t v = {lo, hi}; const cvb2_t r = __builtin_convertvector(v, cvb2_t); return __builtin_bit_cast(unsigned, r); }
__device__ __forceinline__ unsigned f2bf(float f) { return cvt_pk_nv(f, f) & 0xffffu; }
__device__ __forceinline__ ss_t ss_fix(float s) { return (ss_t)(s * 4294967296.0f); }
__device__ __forceinline__ float ss_flt(ss_t v) { return (float)v * (1.0f / 4294967296.0f); }
__device__ __forceinline__ unsigned pk2(float lo, float hi) { return cvt_pk_nv(lo, hi); }
__device__ __forceinline__ float bf2f(bf16 b) { return __builtin_bit_cast(float, (unsigned)b << 16); }
__device__ __forceinline__ float bflo(unsigned u) { return __builtin_bit_cast(float, u << 16); }
__device__ __forceinline__ float bfhi(unsigned u) { return __builtin_bit_cast(float, u & 0xffff0000u); }
__device__ __forceinline__ float sigm(float x) { return 1.0f / (1.0f + __expf(-x)); }
__device__ __forceinline__ float gelu_tanh(float x) { const float z = 0.7978845608028654f * (x + 0.044715f * x * x * x); const float th = 1.0f - 2.0f / (1.0f + __expf(2.0f * z)); return 0.5f * x * (1.0f + th); }
template <int CTRL> __device__ __forceinline__ float dppf(float x) { return __builtin_bit_cast(float, __builtin_amdgcn_mov_dpp(__builtin_bit_cast(int, x), CTRL, 0xf, 0xf, true)); }
__device__ __forceinline__ float half_sum32(float a, float b) { const auto s = __builtin_amdgcn_permlane32_swap(__builtin_bit_cast(unsigned, a), __builtin_bit_cast(unsigned, b), false, false); const unsigned x0 = s[0], x1 = s[1]; return __builtin_bit_cast(float, x0) + __builtin_bit_cast(float, x1); }
__device__ __forceinline__ float half_sum16(float a, float b) { const auto s = __builtin_amdgcn_permlane16_swap(__builtin_bit_cast(unsigned, a), __builtin_bit_cast(unsigned, b), false, false); const unsigned x0 = s[0], x1 = s[1]; return __builtin_bit_cast(float, x0) + __builtin_bit_cast(float, x1); }
__device__ __forceinline__ float half_max32(float a) { const auto s = __builtin_amdgcn_permlane32_swap(__builtin_bit_cast(unsigned, a), __builtin_bit_cast(unsigned, a), false, false); const unsigned x0 = s[0], x1 = s[1]; return fmaxf(__builtin_bit_cast(float, x0), __builtin_bit_cast(float, x1)); }
__device__ __forceinline__ float half_max16(float a) { const auto s = __builtin_amdgcn_permlane16_swap(__builtin_bit_cast(unsigned, a), __builtin_bit_cast(unsigned, a), false, false); const unsigned x0 = s[0], x1 = s[1]; return fmaxf(__builtin_bit_cast(float, x0), __builtin_bit_cast(float, x1)); }
__device__ __forceinline__ float row_sum(float v) { v += dppf<0xB1>(v); v += dppf<0x4E>(v); v += dppf<0x141>(v); v += dppf<0x140>(v); return v; }
__device__ __forceinline__ float row_max(float v) { v = fmaxf(v, dppf<0xB1>(v)); v = fmaxf(v, dppf<0x4E>(v)); v = fmaxf(v, dppf<0x141>(v)); v = fmaxf(v, dppf<0x140>(v)); return v; }
__device__ __forceinline__ float cross_row_sum(float v) { v = half_sum16(v, v); return half_sum32(v, v); }
__device__ __forceinline__ float cross_row_max(float v) { v = half_max16(v); return half_max32(v); }
__device__ __forceinline__ float wave_sum(float v) { return cross_row_sum(row_sum(v)); }
__device__ __forceinline__ float wave_max(float v) { return cross_row_max(row_max(v)); }
#define MFMA16(a, b, c) __builtin_amdgcn_mfma_f32_16x16x32_bf16((a), (b), (c), 0, 0, 0)
__device__ __forceinline__ bf16x8 lds_rowfrag(LAS unsigned char* base, int stride, int row, int kcol) { return *(const LAS bf16x8*)(base + row * stride + kcol * 2); }
__device__ __forceinline__ bf16x8 lds_trfrag(LAS unsigned char* base, int stride, int krow0, int col0, int q, int p) {
    const s16x4 lo = __builtin_amdgcn_ds_read_tr16_b64_v4i16((LAS s16x4*)(base + (krow0 + q) * stride + (col0 + 4 * p) * 2));
    const s16x4 hi = __builtin_amdgcn_ds_read_tr16_b64_v4i16((LAS s16x4*)(base + (krow0 + 4 + q) * stride + (col0 + 4 * p) * 2));
    return __builtin_shufflevector(lo, hi, 0, 1, 2, 3, 4, 5, 6, 7);
}
#define XB_TMO      128
#define XB_XCNT(j)  (256  + 64 * (j))
#define XB_XSUB(j)  (1280 + 64 * (j))
#define XB_XGEN(j)  (2304 + 64 * (j))
#define XB_TOP      3328
#define XB_TOPGEN   3392
#define XCD_BAR_WORDS 3456
#define XB_LSUB(j)  (3520 + 64 * (j))
#define XB_XMASK(j) (4096 + 64 * (j))
#define XB_SPIN_CAP (1u << 18)

__device__ __forceinline__ unsigned xb_ld(unsigned* p)              { return __hip_atomic_load(p, __ATOMIC_RELAXED, __HIP_MEMORY_SCOPE_AGENT); }
__device__ __forceinline__ unsigned xb_add(unsigned* p, unsigned v) { return __hip_atomic_fetch_add(p, v, __ATOMIC_RELAXED, __HIP_MEMORY_SCOPE_AGENT); }
__device__ __forceinline__ unsigned xb_xcc_id() { return (unsigned)__builtin_amdgcn_s_getreg((3 << 11) | 20) & 0xFu; }
#define XB_SPIN(cond, bar) do { unsigned _sp = 0; while (cond) { __builtin_amdgcn_s_sleep(1); \
    if ((++_sp & 255u) == 0u) { if (xb_ld(&(bar)[XB_TMO])) break; if (_sp > XB_SPIN_CAP) { atomicAdd(&(bar)[XB_TMO], 1u); break; } } } } while (0)

struct XcdBarrier {
    unsigned* bar; unsigned x;
    volatile LAS unsigned* st;
};

__device__ __forceinline__ XcdBarrier xcd_barrier_post(unsigned* bar, volatile LAS unsigned* st) {
    XcdBarrier b; b.bar = bar; b.x = xb_xcc_id(); b.st = st;
    if (threadIdx.x == 0) (void)xb_add(&bar[XB_XCNT(b.x)], 1u);
    return b;
}
__device__ __forceinline__ void xcd_barrier_complete(unsigned* bar, unsigned x, unsigned& nloc, unsigned& nx) {
    const unsigned G = gridDim.x * gridDim.y * gridDim.z;
    unsigned sum, cnt, mine, sp = 0u;
    for (;;) {
        sum = 0u; cnt = 0u; mine = 0u;
#pragma unroll
        for (unsigned j = 0; j < 16; ++j) { const unsigned c = xb_ld(&bar[XB_XCNT(j)]); sum += c; cnt += (c > 0u) ? 1u : 0u; mine = (j == x) ? c : mine; }
        if (sum == G) break;
        __builtin_amdgcn_s_sleep(1);
        if ((++sp & 255u) == 0u) { if (xb_ld(&bar[XB_TMO])) break; if (sp > XB_SPIN_CAP) { atomicAdd(&bar[XB_TMO], 1u); break; } }
    }
    nloc = mine > 0u ? mine : 1u; nx = cnt > 0u ? cnt : 1u;
}

__device__ __forceinline__ void xcd_barrier(const XcdBarrier& b) {
    asm volatile("s_waitcnt vmcnt(0)" ::: "memory");
    __syncthreads();
    if (threadIdx.x == 0) {
        unsigned* bar = b.bar;
        __builtin_amdgcn_s_waitcnt(0);
        unsigned nloc = b.st[0], nx = b.st[1];
        if (nloc == 0u) { xcd_barrier_complete(bar, b.x, nloc, nx); b.st[0] = nloc; b.st[1] = nx; }
        const unsigned old = xb_add(&bar[XB_XSUB(b.x)], 1u);
        const unsigned gen = old / nloc;
        if (old + 1u == (gen + 1u) * nloc) {
            __builtin_amdgcn_fence(__ATOMIC_RELEASE, "agent");
            asm volatile("s_waitcnt vmcnt(0)" ::: "memory");
            const unsigned og = xb_add(&bar[XB_TOP], 1u);
            const unsigned tg = og / nx;
            if (og + 1u == (tg + 1u) * nx) xb_add(&bar[XB_TOPGEN], 1u);
            else XB_SPIN(xb_ld(&bar[XB_TOPGEN]) == tg, bar);
            __builtin_amdgcn_fence(__ATOMIC_ACQUIRE, "agent");
            xb_add(&bar[XB_XGEN(b.x)], 1u);
            asm volatile("s_waitcnt vmcnt(0)" ::: "memory");
        } else {
            XB_SPIN(xb_ld(&bar[XB_XGEN(b.x)]) == gen, bar);
            __builtin_amdgcn_fence(__ATOMIC_ACQUIRE, "agent");
            asm volatile("s_waitcnt vmcnt(0)" ::: "memory");
        }
    }
    __syncthreads();
}

__device__ __forceinline__ void res_barrier(const XcdBarrier& b, volatile LAS unsigned* local_ok) {
    if (*local_ok == 0u) { xcd_barrier(b); return; }
    asm volatile("s_waitcnt vmcnt(0)" ::: "memory");
    __syncthreads();
    if (threadIdx.x == 0) {
        unsigned* bar = b.bar;
        __builtin_amdgcn_s_waitcnt(0);
        const unsigned r = blockIdx.x & 7u, n = gridDim.x >> 3;
        const unsigned old = xb_add(&bar[XB_LSUB(r)], 1u);
        const unsigned target = (old / n + 1u) * n;
        XB_SPIN(xb_ld(&bar[XB_LSUB(r)]) < target, bar);
        __builtin_amdgcn_fence(__ATOMIC_ACQUIRE, "agent");
        asm volatile("s_waitcnt vmcnt(0)" ::: "memory");
    }
    __syncthreads();
}

struct Args { const float* in[28]; float* out; unsigned char* ws; };
enum { I_X = 0, I_MEM, I_POS, I_GMIX, I_WIN, I_WRET, I_WRNN, I_WMIX, I_CONVW, I_CONVB, I_LWA, I_LBA, I_LWX, I_LBX, I_LAM, I_GX, I_GMEM, I_WXQ, I_WXK, I_WXV, I_WXO, I_GFFN, I_WPQ, I_SK1, I_SK2, I_PU, I_PV, I_GFIN };
struct Frame {
    LAS unsigned char* lds;
    int tid, lane, wave, vcu, G;
};
__device__ __forceinline__ Frame frame_local(const Frame& F0) { Frame F = F0; int t = F0.tid; asm volatile("" : "+v"(t)); F.tid = t; F.lane = t & 63; F.wave = __builtin_amdgcn_readfirstlane(t >> 6); return F; }
typedef const __attribute__((address_space(4))) unsigned long long* KArg;
__device__ __forceinline__ KArg ka_get() { KArg p = (KArg)__builtin_amdgcn_kernarg_segment_ptr(); asm volatile("" : "+s"(p)); return p; }
#define PH_BEGIN KArg const ka_ = ka_get(); GAS unsigned char* const ws_ = (GAS unsigned char*)ka_[29]; float* const X_ = (float*)(GAS float*)ka_[28]; (void)X_; (void)ws_
#define WSP(type, off) ((type*)(GAS type*)(ws_ + (off)))
#define INP(i) ((const float*)(GAS const float*)ka_[i])

template <bool HASG>
__device__ __forceinline__ void p0_transpose_item(const float* W, int K, int N, bf16* WT, int row_off, LAS float* scr, int item, int lane, const float* gk = nullptr) {
    const int nblk = N / 32, kb = item / nblk, nb = item % nblk, k0 = 64 * kb, n0 = 32 * nb;
    const int c = lane & 7;
    float wv_[32];
#pragma unroll
    for (int i = 0; i < 32; ++i) wv_[i] = W[(size_t)(k0 + 2 * i + (lane >> 5)) * N + n0 + (lane & 31)];
    f32x4 ga = {1.f, 1.f, 1.f, 1.f}, gb = {1.f, 1.f, 1.f, 1.f};
    if (HASG) { ga = *(const f32x4*)(gk + k0 + 8 * c); gb = *(const f32x4*)(gk + k0 + 8 * c + 4); }
#pragma unroll
    for (int i = 0; i < 32; ++i) scr[(2 * i + (lane >> 5)) * 33 + (lane & 31)] = wv_[i];
    LDS_WAIT(); asm volatile("" ::: "memory");
#pragma unroll
    for (int j = 0; j < 4; ++j) { const int n = (lane >> 3) + 8 * j; const LAS float* s = scr + (8 * c) * 33 + n;
        v4u o; o.x = pk2(s[0 * 33] * ga.x, s[1 * 33] * ga.y); o.y = pk2(s[2 * 33] * ga.z, s[3 * 33] * ga.w); o.z = pk2(s[4 * 33] * gb.x, s[5 * 33] * gb.y); o.w = pk2(s[6 * 33] * gb.z, s[7 * 33] * gb.w);
        *(GAS v4u*)(WT + (size_t)(row_off + n0 + n) * K + k0 + 8 * c) = o; }
    LDS_WAIT(); asm volatile("" ::: "memory");
}
__device__ __forceinline__ void conv_rows_fp8(const float* src, unsigned char* dst, float* sc, int gw, int ngw, int lane) {
    for (int r0 = 4 * gw; r0 < 16384; r0 += 4 * ngw) {
        f32x4 v[4][4]; float mx[4];
#pragma unroll
        for (int q = 0; q < 4; ++q) { const f32x4* p = (const f32x4*)(src + (size_t)(r0 + q) * 1024) + 4 * lane;
#pragma unroll
            for (int j = 0; j < 4; ++j) v[q][j] = p[j]; }
#pragma unroll
        for (int q = 0; q < 4; ++q) { float m = 0.f;
#pragma unroll
            for (int j = 0; j < 4; ++j) m = fmaxf(fmaxf(m, fmaxf(fabsf(v[q][j].x), fabsf(v[q][j].y))), fmaxf(fabsf(v[q][j].z), fabsf(v[q][j].w)));
            mx[q] = wave_max(m); }
#pragma unroll
        for (int q = 0; q < 4; ++q) { const float s = mx[q] > 0.f ? 448.0f / mx[q] : 1.0f; v4u o4;
#pragma unroll
            for (int j = 0; j < 4; ++j) { int w = 0; w = __builtin_amdgcn_cvt_pk_fp8_f32(v[q][j].x * s, v[q][j].y * s, w, false); w = __builtin_amdgcn_cvt_pk_fp8_f32(v[q][j].z * s, v[q][j].w * s, w, true); o4[j] = (unsigned)w; }
            *(v4u*)(dst + (size_t)(lane >> 3) * SLICE_BYTES + (size_t)(r0 + q) * 128 + 16 * (lane & 7)) = o4;
            if (lane == 0) sc[r0 + q] = mx[q] > 0.f ? mx[q] * (1.0f / 448.0f) : 1.0f; }
    }
}
__device__ __forceinline__ unsigned pack_i8x4(float a, float b, float c2, float d2) {
    const int ia = __float2int_rn(a), ib = __float2int_rn(b), ic = __float2int_rn(c2), id = __float2int_rn(d2);
    return ((unsigned)ia & 0xffu) | (((unsigned)ib & 0xffu) << 8) | (((unsigned)ic & 0xffu) << 16) | ((unsigned)id << 24);
}
__device__ __forceinline__ void conv_rows_i8(const float* src, unsigned char* dst, float* sc, int gw, int ngw, int lane, const float* gain) {
    f32x4 gf[4];
#pragma unroll
    for (int j = 0; j < 4; ++j) gf[j] = ((const f32x4*)gain + 4 * lane)[j];
    for (int r0 = 4 * gw; r0 < 16384; r0 += 4 * ngw) {
        f32x4 v[4][4]; float mx[4];
#pragma unroll
        for (int q = 0; q < 4; ++q) { const f32x4* p = (const f32x4*)(src + (size_t)(r0 + q) * 1024) + 4 * lane;
#pragma unroll
            for (int j = 0; j < 4; ++j) v[q][j] = p[j] * gf[j]; }
#pragma unroll
        for (int q = 0; q < 4; ++q) { float m = 0.f;
#pragma unroll
            for (int j = 0; j < 4; ++j) m = fmaxf(fmaxf(m, fmaxf(fabsf(v[q][j].x), fabsf(v[q][j].y))), fmaxf(fabsf(v[q][j].z), fabsf(v[q][j].w)));
            mx[q] = wave_max(m); }
#pragma unroll
        for (int q = 0; q < 4; ++q) { const float s = mx[q] > 0.f ? 127.0f / mx[q] : 1.0f; v4u o4;
#pragma unroll
            for (int j = 0; j < 4; ++j) o4[j] = pack_i8x4(v[q][j].x * s, v[q][j].y * s, v[q][j].z * s, v[q][j].w * s);
            *(v4u*)(dst + (size_t)(lane >> 3) * SLICE_BYTES + (size_t)(r0 + q) * 128 + 16 * (lane & 7)) = o4;
            if (lane == 0) sc[r0 + q] = mx[q] > 0.f ? mx[q] * (1.0f / 127.0f) : 1.0f; }
    }
}
__device__ __forceinline__ void norm_rows(const float* src, const float* gain, bf16* dst, float* copy_dst, int nrows, int gw, int ngw, int lane) {
    f32x4 gg4[4];
#pragma unroll
    for (int j = 0; j < 4; ++j) gg4[j] = ((const f32x4*)gain + lane)[64 * j];
    f32x4 v[4];
    if (gw < nrows) {
#pragma unroll
        for (int j = 0; j < 4; ++j) v[j] = ((const f32x4*)(src + (size_t)gw * D) + lane)[64 * j]; }
    for (int m = gw; m < nrows; m += ngw) {
        const int mn = (m + ngw < nrows) ? m + ngw : m;
        f32x4 vn[4];
#pragma unroll
        for (int j = 0; j < 4; ++j) vn[j] = ((const f32x4*)(src + (size_t)mn * D) + lane)[64 * j];
        KEEP4(v[0], v[1], v[2], v[3]);
        float s = 0.f;
#pragma unroll
        for (int j = 0; j < 4; ++j) s += (v[j].x * v[j].x + v[j].y * v[j].y) + (v[j].z * v[j].z + v[j].w * v[j].w);
        const float rs = rsqrtf(wave_sum(s) * (1.f / D) + EPS);
        if (copy_dst) { f32x4* cr = (f32x4*)(copy_dst + (size_t)m * D) + lane;
#pragma unroll
            for (int j = 0; j < 4; ++j) cr[64 * j] = v[j]; }
        v2u* o = (v2u*)(dst + (size_t)m * D) + lane;
#pragma unroll
        for (int j = 0; j < 4; ++j) { const f32x4 gg = gg4[j]; v2u w; w.x = pk2(v[j].x * rs * gg.x, v[j].y * rs * gg.y); w.y = pk2(v[j].z * rs * gg.z, v[j].w * rs * gg.w); o[64 * j] = w; }
#pragma unroll
        for (int j = 0; j < 4; ++j) v[j] = vn[j];
    }
}
__device__ __forceinline__ void rotary_tables(const Frame& F0) {
    PH_BEGIN; const Frame F = frame_local(F0);
    if (blockIdx.x == 0 && F.tid < 64) { const double f = exp2(-(double)F.tid * (2.0 / 128.0) * 13.287712379549449) * 0.15915494309189535; const double f128 = 128.0 * f;
        WSP(float, WS_COS)[F.tid] = (float)f; WSP(float, WS_COS)[64 + F.tid] = (float)(f128 - floor(f128)); }
    {
        const int gw = F.vcu * NWAVES + F.wave, ngw = F.G * NWAVES, lane = F.lane; const float* src = INP(I_X); bf16* dst = WSP(bf16, WS_XN); ss_t* ss0 = WSP(ss_t, WS_SS0);
        f32x4 v[4];
        if (gw < T) {
#pragma unroll
            for (int j = 0; j < 4; ++j) v[j] = ((const f32x4*)(src + (size_t)gw * D) + lane)[64 * j]; }
        for (int m = gw; m < T; m += ngw) {
            const int mn = (m + ngw < T) ? m + ngw : m; f32x4 vn[4];
#pragma unroll
            for (int j = 0; j < 4; ++j) vn[j] = ((const f32x4*)(src + (size_t)mn * D) + lane)[64 * j];
            KEEP4(v[0], v[1], v[2], v[3]);
            float s = 0.f;
#pragma unroll
            for (int j = 0; j < 4; ++j) s += (v[j].x * v[j].x + v[j].y * v[j].y) + (v[j].z * v[j].z + v[j].w * v[j].w);
            s = wave_sum(s);
            v2u* o = (v2u*)(dst + (size_t)m * D) + lane;
#pragma unroll
            for (int j = 0; j < 4; ++j) { v2u w; w.x = pk2(v[j].x, v[j].y); w.y = pk2(v[j].z, v[j].w); o[64 * j] = w; }
            if (lane == 0) ss0[m] = ss_fix(s);
#pragma unroll
            for (int j = 0; j < 4; ++j) v[j] = vn[j];
        }
    }
}
__device__ __forceinline__ void phase_prologue(const Frame& F0, int l) {
    PH_BEGIN; const Frame F = frame_local(F0);
    LAS float* scr = (LAS float*)(F.lds + F.wave * 16384);
    const int gw = F.vcu * NWAVES + F.wave, NGW = F.G * NWAVES;
    constexpr int I_IN = 16 * (INC / 32), I_SQ = 16 * 32, I_LRU = 8;
    constexpr int NITEMS = I_IN + 6 * I_SQ + 16 * I_LRU;
    for (int it = gw; it < NITEMS; it += NGW) {
        int r = it;
        if (r < I_IN) { p0_transpose_item<true>(INP(I_WIN) + (size_t)l * D * INC, D, INC, WSP(bf16, WS_WIN), 0, scr, r, F.lane, INP(I_GMIX) + l * D); continue; } r -= I_IN;
#define SQ_ITEM(idx, off) if (r < I_SQ) { p0_transpose_item<false>(INP(idx) + (size_t)l * D * D, D, D, WSP(bf16, off), 0, scr, r, F.lane); continue; } r -= I_SQ;
        SQ_ITEM(I_WRET, WS_WRET) SQ_ITEM(I_WRNN, WS_WRNN) SQ_ITEM(I_WMIX, WS_WMIX) SQ_ITEM(I_WXK, WS_WXK) SQ_ITEM(I_WXV, WS_WXV) SQ_ITEM(I_WXO, WS_WXO)
#undef SQ_ITEM
        { const int blk = r / I_LRU, sub = r % I_LRU;
          const float* src = INP(blk < 8 ? I_LWA : I_LWX) + (size_t)l * 8 * 128 * 128 + (size_t)(blk & 7) * 128 * 128;
          bf16* dst = WSP(bf16, blk < 8 ? WS_LWA : WS_LWX) + (size_t)(blk & 7) * 128 * 128;
          p0_transpose_item<false>(src, 128, 128, dst, 0, scr, sub, F.lane); }
    }
    const size_t gt = (size_t)F.vcu * NTHR + F.tid, GN = (size_t)F.G * NTHR;
    conv_rows_i8(INP(I_PU) + (size_t)l * 16384 * 1024, WSP(unsigned char, WS_PU8), WSP(float, WS_SCU), gw, NGW, F.lane, INP(I_GFFN) + l * D);
    conv_rows_fp8(INP(I_PV) + (size_t)l * 16384 * 1024, WSP(unsigned char, WS_PV8), WSP(float, WS_SCV), gw, NGW, F.lane);
    norm_rows(INP(I_MEM), INP(I_GMEM) + l * D, WSP(bf16, WS_MEMN), nullptr, 256, gw, NGW, F.lane);
    for (size_t i = gt; i < (size_t)T; i += GN) { WSP(ss_t, WS_SSA)[i] = 0ull; WSP(ss_t, WS_SSB)[i] = 0ull; WSP(ss_t, WS_SSC)[(size_t)l * T + i] = 0ull; }
}

__device__ __forceinline__ float sigm_fast(float x) { return __builtin_amdgcn_rcpf(1.0f + __builtin_amdgcn_exp2f(-1.4426950408889634f * x)); }
constexpr int RS_QK = 288, RS_V = 544, R_QS = 0, R_KS = 36864, R_VS = 73728, R_RED = 143360;
struct RotIn { v4u xa[2], xb[2]; };
struct CsIn { f32x4 c0[2], c1[2], s0[2], s1[2]; };
__device__ __forceinline__ void rot_load(RotIn& r, const bf16* src, int tid) {
#pragma unroll
    for (int rep = 0; rep < 2; ++rep) { const int it = tid + rep * NTHR; const bf16* rp = src + (size_t)(it >> 3) * 1024 + 8 * (it & 7); r.xa[rep] = *(const v4u*)rp; r.xb[rep] = *(const v4u*)(rp + 64); }
}
struct FrIn { f32x4 f[2], g[2]; int pos[2]; };
__device__ __forceinline__ void fr_load(FrIn& r, const float* fr, const int* posb, int tid) {
    const int p8 = tid & 7;
    r.f[0] = *(const f32x4*)(fr + 8 * p8); r.f[1] = *(const f32x4*)(fr + 8 * p8 + 4); r.g[0] = *(const f32x4*)(fr + 64 + 8 * p8); r.g[1] = *(const f32x4*)(fr + 64 + 8 * p8 + 4);
#pragma unroll
    for (int rep = 0; rep < 2; ++rep) r.pos[rep] = posb[(tid + rep * NTHR) >> 3];
}
__device__ __forceinline__ void cs_make(CsIn& r, const FrIn& fi) {
#pragma unroll
    for (int rep = 0; rep < 2; ++rep) { const float hi = (float)(fi.pos[rep] >> 7), lo = (float)(fi.pos[rep] & 127);
#pragma unroll
        for (int w = 0; w < 4; ++w) {
            const float r0 = __builtin_amdgcn_fractf(hi * fi.g[0][w]) + lo * fi.f[0][w], r1 = __builtin_amdgcn_fractf(hi * fi.g[1][w]) + lo * fi.f[1][w];
            r.c0[rep][w] = __builtin_amdgcn_cosf(r0); r.s0[rep][w] = __builtin_amdgcn_sinf(r0); r.c1[rep][w] = __builtin_amdgcn_cosf(r1); r.s1[rep][w] = __builtin_amdgcn_sinf(r1); } }
}
#define KEEP_FR(r) do { KEEP4((r).f[0], (r).f[1], (r).g[0], (r).g[1]); KEEP2((r).pos[0], (r).pos[1]); } while (0)
__device__ __forceinline__ void v_load(v4u (&t8)[8], const bf16* src, int tid) {
#pragma unroll
    for (int rep = 0; rep < 8; ++rep) { const int it = tid + rep * NTHR; t8[rep] = *(const v4u*)(src + (size_t)(it >> 5) * 1024 + 8 * (it & 31)); }
}
__device__ __forceinline__ void v_store(LAS unsigned char* dst, const v4u (&t8)[8], int tid) {
#pragma unroll
    for (int rep = 0; rep < 8; ++rep) { const int it = tid + rep * NTHR; *(LAS v4u*)(dst + (it >> 5) * RS_V + 16 * (it & 31)) = t8[rep]; }
}
template <int MODE>
__device__ __forceinline__ void rot_store(LAS unsigned char* dst, const RotIn& r, const CsIn& cs, float log2g, int tid) {
#pragma unroll
    for (int rep = 0; rep < 2; ++rep) {
        const int it = tid + rep * NTHR, j = it >> 3, p8 = it & 7;
        const v4u xa = r.xa[rep], xb = r.xb[rep]; const f32x4 c0 = cs.c0[rep], c1 = cs.c1[rep], s0 = cs.s0[rep], s1 = cs.s1[rep];
        float sc = (MODE == 0) ? 1.0f : 0.08838834764831845f;
        if (MODE == 2) sc *= exp2f((float)(127 - j) * log2g);
        v4u o1, o2;
#pragma unroll
        for (int w = 0; w < 4; ++w) {
            const float a_lo = bflo(xa[w]), a_hi = bfhi(xa[w]), b_lo = bflo(xb[w]), b_hi = bfhi(xb[w]);
            const float cl = (w < 2) ? c0[2 * w] : c1[2 * w - 4], ch = (w < 2) ? c0[2 * w + 1] : c1[2 * w - 3];
            const float sl = (w < 2) ? s0[2 * w] : s1[2 * w - 4], sh = (w < 2) ? s0[2 * w + 1] : s1[2 * w - 3];
            o1[w] = pk2((a_lo * cl - b_lo * sl) * sc, (a_hi * ch - b_hi * sh) * sc);
            o2[w] = pk2((b_lo * cl + a_lo * sl) * sc, (b_hi * ch + a_hi * sh) * sc);
        }
        *(LAS v4u*)(dst + j * RS_QK + 16 * p8) = o1;
        *(LAS v4u*)(dst + j * RS_QK + 128 + 16 * p8) = o2;
    }
}
#define KEEP_ROT(r) KEEP4((r).xa[0], (r).xa[1], (r).xb[0], (r).xb[1])
__device__ __forceinline__ float ret_log2g(int h) { return log2f(1.0f - exp2f(-5.0f - (float)h)); }

__device__ __forceinline__ void r1_unit(const Frame& F0, int c, int h) {
    PH_BEGIN; const Frame F = frame_local(F0);
    const int tid = F.tid, wid = F.wave, lane = F.lane, g = lane >> 4, l15 = lane & 15, q = l15 >> 2, p = l15 & 3;
    const int t0 = c * 128;
    LAS unsigned char* Ks = F.lds + R_KS; LAS unsigned char* Vs = F.lds + R_VS;
    const float log2g = ret_log2g(h);
    {   RotIn rk; CsIn cs; FrIn fi; v4u t8[8];
        fr_load(fi, WSP(float, WS_COS), (const int*)INP(I_POS) + t0, tid); rot_load(rk, WSP(bf16, WS_Z) + (size_t)t0 * 1024 + 512 + h * 128, tid);
        v_load(t8, WSP(bf16, WS_Z + ZSTRIDE) + (size_t)t0 * 1024 + h * 256, tid);
        KEEP_FR(fi); cs_make(cs, fi); KEEP_ROT(rk); KEEP8(t8);
        rot_store<2>(Ks, rk, cs, log2g, tid); v_store(Vs, t8, tid); }
    __syncthreads();
    const int we = wid >> 1, wd = wid & 1;
    f32x4 acc[4][4];
#pragma unroll
    for (int m = 0; m < 4; ++m)
#pragma unroll
        for (int n = 0; n < 4; ++n) acc[m][n] = (f32x4){0.f, 0.f, 0.f, 0.f};
#pragma unroll
    for (int ks = 0; ks < 4; ++ks) {
        bf16x8 av[4], bv[4];
#pragma unroll
        for (int m = 0; m < 4; ++m) av[m] = lds_trfrag(Vs, RS_V, 32 * ks + 8 * g, 64 * we + 16 * m, q, p);
#pragma unroll
        for (int n = 0; n < 4; ++n) bv[n] = lds_trfrag(Ks, RS_QK, 32 * ks + 8 * g, 64 * wd + 16 * n, q, p);
#pragma unroll
        for (int m = 0; m < 4; ++m)
#pragma unroll
            for (int n = 0; n < 4; ++n) acc[m][n] = MFMA16(av[m], bv[n], acc[m][n]);
    }
    bf16* kv = WSP(bf16, WS_KV) + (size_t)(c * 4 + h) * 32768;
    __syncthreads();
    LAS unsigned char* OT = F.lds;
#pragma unroll
    for (int m = 0; m < 4; ++m)
#pragma unroll
        for (int n = 0; n < 4; ++n)
#pragma unroll
            for (int r = 0; r < 4; ++r) *(LAS bf16*)(OT + (64 * we + 16 * m + 4 * g + r) * 272 + (64 * wd + 16 * n + l15) * 2) = (bf16)f2bf(acc[m][n][r]);
    __syncthreads();
#pragma unroll
    for (int i = 0; i < 8; ++i) { const int idx = tid + NTHR * i, row = idx >> 4, pc = idx & 15; *(v4u*)(kv + (size_t)row * 128 + 8 * pc) = *(const LAS v4u*)(OT + row * 272 + 16 * pc); }
    __syncthreads();
}

__device__ __forceinline__ void r2_scan(const Frame& F0) {
    PH_BEGIN; const Frame F = frame_local(F0);
    if (F.tid < 256)
    for (int p = blockIdx.x * 256 + F.tid; p < 65536; p += F.G * 256) {
        const int h = p >> 14; const float g128 = exp2f(128.0f * ret_log2g(h));
        unsigned* pp = WSP(unsigned, WS_KV) + p; float s0 = 0.f, s1 = 0.f;
        unsigned va[32], vb[32];
#pragma unroll
        for (int i = 0; i < 32; ++i) va[i] = pp[(size_t)i * 65536];
#pragma unroll
        for (int cb = 0; cb < 128; cb += 64) {
#pragma unroll
            for (int i = 0; i < 32; ++i) vb[i] = pp[(size_t)(cb + 32 + i) * 65536];
#pragma unroll
            for (int i = 0; i < 32; ++i) { const float k0 = bflo(va[i]), k1 = bfhi(va[i]); pp[(size_t)(cb + i) * 65536] = pk2(s0, s1); s0 = g128 * s0 + k0; s1 = g128 * s1 + k1; }
            if (cb + 64 < 128) {
#pragma unroll
                for (int i = 0; i < 32; ++i) va[i] = pp[(size_t)(cb + 64 + i) * 65536]; }
#pragma unroll
            for (int i = 0; i < 32; ++i) { const float k0 = bflo(vb[i]), k1 = bfhi(vb[i]); pp[(size_t)(cb + 32 + i) * 65536] = pk2(s0, s1); s0 = g128 * s0 + k0; s1 = g128 * s1 + k1; }
        }
    }
}

template <bool DRY>
__device__ __forceinline__ void r3_unit(const Frame& F0, int c, int h) {
    PH_BEGIN; const Frame F = frame_local(F0);
    const int tid = F.tid, wid = F.wave, lane = F.lane, g = lane >> 4, l15 = lane & 15, q = l15 >> 2, p = l15 & 3;
    const int t0 = c * 128;
    LAS unsigned char* Qs = F.lds + R_QS; LAS unsigned char* Ks = F.lds + R_KS; LAS unsigned char* Vs = F.lds + R_VS; LAS float* RED = (LAS float*)(F.lds + R_RED);
    const float log2g = ret_log2g(h);
    const int wr = wid >> 2, wc = wid & 3;
    const bf16* sp = WSP(bf16, WS_KV) + (size_t)(c * 4 + h) * 32768 + (size_t)(64 * wc + l15) * 128 + 8 * g;
    bf16x8 bsr[4][4];
#pragma unroll
    for (int ks = 0; ks < 4; ++ks)
#pragma unroll
        for (int n = 0; n < 4; ++n) bsr[ks][n] = *(const bf16x8*)(sp + n * 16 * 128 + 32 * ks);
    {   RotIn rq, rk; CsIn cs; FrIn fi; v4u t8[8];
        fr_load(fi, WSP(float, WS_COS), (const int*)INP(I_POS) + t0, tid); rot_load(rq, WSP(bf16, WS_Z) + (size_t)t0 * 1024 + h * 128, tid); rot_load(rk, WSP(bf16, WS_Z) + (size_t)t0 * 1024 + 512 + h * 128, tid);
        v_load(t8, WSP(bf16, WS_Z + ZSTRIDE) + (size_t)t0 * 1024 + h * 256, tid);
        KEEP_FR(fi); cs_make(cs, fi); KEEP_ROT(rq); KEEP_ROT(rk); KEEP8(t8);
        rot_store<0>(Qs, rq, cs, log2g, tid); rot_store<1>(Ks, rk, cs, log2g, tid); v_store(Vs, t8, tid); }
    __syncthreads();
    f32x4 accO[4][4], accS[4][2];
#pragma unroll
    for (int m = 0; m < 4; ++m) {
#pragma unroll
        for (int n = 0; n < 4; ++n) accO[m][n] = (f32x4){0.f, 0.f, 0.f, 0.f};
        accS[m][0] = (f32x4){0.f, 0.f, 0.f, 0.f}; accS[m][1] = (f32x4){0.f, 0.f, 0.f, 0.f}; }
#pragma unroll
    for (int ks = 0; ks < 4; ++ks) {
        bf16x8 av[4], bk[2];
#pragma unroll
        for (int m = 0; m < 4; ++m) av[m] = lds_rowfrag(Qs, RS_QK, 64 * wr + 16 * m + l15, 32 * ks + 8 * g);
#pragma unroll
        for (int n = 0; n < 2; ++n) bk[n] = lds_rowfrag(Ks, RS_QK, 32 * wc + 16 * n + l15, 32 * ks + 8 * g);
#pragma unroll
        for (int m = 0; m < 4; ++m) {
#pragma unroll
            for (int n = 0; n < 4; ++n) accO[m][n] = MFMA16(av[m], bsr[ks][n], accO[m][n]);
#pragma unroll
            for (int n = 0; n < 2; ++n) accS[m][n] = MFMA16(av[m], bk[n], accS[m][n]);
        }
        asm volatile("" ::: "memory");
    }
    bf16* gret = WSP(bf16, WS_Z + 2 * ZSTRIDE) + (size_t)t0 * 1024 + h * 256;
    v4u gvr[8];
#pragma unroll
    for (int i = 0; i < 8; ++i) { const int cidx = tid + NTHR * i; gvr[i] = *(const v4u*)(gret + (size_t)(cidx >> 5) * 1024 + 8 * (cidx & 31)); }
#pragma unroll
    for (int m = 0; m < 4; ++m)
#pragma unroll
        for (int r = 0; r < 4; ++r) { const float qd = exp2f((float)(64 * wr + 16 * m + 4 * g + r + 1) * log2g);
#pragma unroll
            for (int n = 0; n < 4; ++n) accO[m][n][r] *= qd; }
    __syncthreads();
    LAS unsigned char* Ps = Ks;
#pragma unroll
    for (int m = 0; m < 4; ++m)
#pragma unroll
        for (int n = 0; n < 2; ++n)
#pragma unroll
            for (int r = 0; r < 4; ++r) { const int i = 64 * wr + 16 * m + 4 * g + r, j = 32 * wc + 16 * n + l15;
                const float dm = (i >= j) ? exp2f((float)(i - j) * log2g) : 0.f;
                *(LAS bf16*)(Ps + i * RS_QK + j * 2) = (bf16)f2bf(accS[m][n][r] * dm); }
    __syncthreads();
#pragma unroll 1
    for (int ks = 0; ks < 4; ++ks) {
        bf16x8 av[4], bv[4];
#pragma unroll
        for (int m = 0; m < 4; ++m) av[m] = lds_rowfrag(Ps, RS_QK, 64 * wr + 16 * m + l15, 32 * ks + 8 * g);
#pragma unroll
        for (int n = 0; n < 4; ++n) bv[n] = lds_trfrag(Vs, RS_V, 32 * ks + 8 * g, 64 * wc + 16 * n, q, p);
#pragma unroll
        for (int m = 0; m < 4; ++m)
#pragma unroll
            for (int n = 0; n < 4; ++n) accO[m][n] = MFMA16(av[m], bv[n], accO[m][n]);
    }
#pragma unroll
    for (int m = 0; m < 4; ++m)
#pragma unroll
        for (int r = 0; r < 4; ++r) { float s1 = 0.f, s2 = 0.f;
#pragma unroll
            for (int n = 0; n < 4; ++n) { const float v = accO[m][n][r]; s1 += v; s2 += v * v; }
            s1 = row_sum(s1); s2 = row_sum(s2);
            if (l15 == 0) { const int row = 64 * wr + 16 * m + 4 * g + r; RED[(row * 4 + wc) * 2] = s1; RED[(row * 4 + wc) * 2 + 1] = s2; } }
    __syncthreads();
    LAS unsigned char* OT = F.lds + R_QS;
#pragma unroll
    for (int m = 0; m < 4; ++m)
#pragma unroll
        for (int r = 0; r < 4; ++r) { const int row = 64 * wr + 16 * m + 4 * g + r;
            const f32x4 ra = *(const LAS f32x4*)(RED + row * 8), rb = *(const LAS f32x4*)(RED + row * 8 + 4);
            const float s1 = (ra[0] + ra[2]) + (rb[0] + rb[2]), s2 = (ra[1] + ra[3]) + (rb[1] + rb[3]);
            const float mu = s1 * (1.f / 256.f), var = fmaxf(s2 * (1.f / 256.f) - mu * mu, 0.f), rstd = rsqrtf(var + EPS);
#pragma unroll
            for (int n = 0; n < 4; ++n) *(LAS bf16*)(OT + row * 528 + (64 * wc + 16 * n + l15) * 2) = (bf16)f2bf((accO[m][n][r] - mu) * rstd); }
    __syncthreads();
#pragma unroll
    for (int i = 0; i < 8; ++i) { const int cidx = tid + NTHR * i, row = cidx >> 5, ch = cidx & 31;
        const v4u ov = *(const LAS v4u*)(OT + row * 528 + 16 * ch); v4u* gp = (v4u*)(gret + (size_t)row * 1024 + 8 * ch); const v4u gv = gvr[i]; v4u res;
#pragma unroll
        for (int w = 0; w < 4; ++w) { const unsigned ow = ov[w], gw_ = gv[w]; const float g0 = bflo(gw_), g1 = bfhi(gw_);
            res[w] = pk2(bflo(ow) * g0 * sigm_fast(g0), bfhi(ow) * g1 * sigm_fast(g1)); }
        if (!DRY || res[0] == 0x12345678u) *gp = res; }
    __syncthreads();
}

constexpr int L_XCF = 0, L_AF = 33792, L_XCB = 67584, L_SEG = 67584 + 18432, L_CAR = L_SEG + 4096, L_CW = L_CAR + 1024, L_LAF = L_CW + 2560;
__device__ __forceinline__ float gelu_tanh_fast(float x) { const float z = 0.7978845608028654f * (x + 0.044715f * x * x * x); return x * (1.0f - __builtin_amdgcn_rcpf(1.0f + __builtin_amdgcn_exp2f(2.885390081777927f * z))); }
#define LRU_LAB(unit) (WSP(v4u, ((unit) < 128 ? WS_LA : WS_LB)) + (size_t)((unit) & 127) * (8 * NTHR * 4))
__device__ __forceinline__ void lru_strip_agg(const Frame& F0, int l, int sg, int nb) {
    PH_BEGIN; const Frame F = frame_local(F0);
    const int tid = F.tid, wid = F.wave, lane = F.lane, g = lane >> 4, l15 = lane & 15;
    const int c0 = nb * 128;
    LAS float* XCF = (LAS float*)(F.lds + L_XCF); LAS float* AF = (LAS float*)(F.lds + L_AF); LAS unsigned char* XCB = F.lds + L_XCB; LAS float* SEG = (LAS float*)(F.lds + L_SEG);
    LAS float* CW = (LAS float*)(F.lds + L_CW); LAS unsigned* ABW = (LAS unsigned*)(F.lds + L_LAF);
    const int wt = wid >> 2, wd = wid & 3;
    bf16x8 fba[4][2], fbx[4][2];
    {   const bf16* wa = WSP(bf16, WS_LWA) + (size_t)nb * 16384 + (size_t)(32 * wd + l15) * 128 + 8 * g;
        const bf16* wx = WSP(bf16, WS_LWX) + (size_t)nb * 16384 + (size_t)(32 * wd + l15) * 128 + 8 * g;
#pragma unroll
        for (int ks = 0; ks < 4; ++ks)
#pragma unroll
            for (int n = 0; n < 2; ++n) { fba[ks][n] = *(const bf16x8*)(wa + n * 16 * 128 + 32 * ks); fbx[ks][n] = *(const bf16x8*)(wx + n * 16 * 128 + 32 * ks); } }
    float bav[2], bxv[2], spv[2];
#pragma unroll
    for (int n = 0; n < 2; ++n) { const int ch = l * 1024 + c0 + 32 * wd + 16 * n + l15;
        bav[n] = -1.4426950408889634f * INP(I_LBA)[ch]; bxv[n] = -1.4426950408889634f * INP(I_LBX)[ch];
        spv[n] = -11.541560327111707f * log1pf(expf(-INP(I_LAM)[ch])); }
    for (int i = tid; i < 640; i += NTHR) CW[i] = (i < 512) ? INP(I_CONVW)[(size_t)(l * 4 + (i >> 7)) * 1024 + c0 + (i & 127)] : INP(I_CONVB)[l * 1024 + c0 + (i - 512)];
    const int sd = tid & 127, sseg = tid >> 7;
    float Astrip = 1.f, Bstrip = 0.f;
    const int* pos = (const int*)INP(I_POS);
    const bf16* xr = WSP(bf16, WS_Z + 3 * ZSTRIDE);
    v4u* labo = LRU_LAB(sg * 8 + nb) + tid;
    v4u xq[4][2];
    {   const int t = tid >> 3, cc = c0 + 16 * (tid & 7);
#pragma unroll
        for (int k = 0; k < 4; ++k) { const int tt = max(sg * 512 + t - 3 + k, 0); xq[k][0] = *(const v4u*)(xr + (size_t)tt * 1024 + cc); xq[k][1] = *(const v4u*)(xr + (size_t)tt * 1024 + cc + 8); } }
    __syncthreads();
#pragma unroll 1
    for (int tl = 0; tl < 8; ++tl) {
        const int t0 = sg * 512 + tl * 64;
        typedef int v4i_t __attribute__((ext_vector_type(4)));
        v4i_t posv[2];
#pragma unroll
        for (int m = 0; m < 2; ++m) posv[m] = *(const v4i_t*)(pos + t0 + 32 * wt + 16 * m + 4 * g);
        v4u xn[4][2];
        {   const int t = tid >> 3, cc = c0 + 16 * (tid & 7), tb = sg * 512 + min(tl + 1, 7) * 64;
#pragma unroll
            for (int k = 0; k < 4; ++k) { const int tt = tb + t - 3 + k; xn[k][0] = *(const v4u*)(xr + (size_t)tt * 1024 + cc); xn[k][1] = *(const v4u*)(xr + (size_t)tt * 1024 + cc + 8); } }
        {
            const int t = tid >> 3, cg = tid & 7;
            f32x4 acc4[4];
#pragma unroll
            for (int i = 0; i < 4; ++i) acc4[i] = *(const LAS f32x4*)(CW + 512 + 16 * cg + 4 * i);
#pragma unroll
            for (int k = 0; k < 4; ++k) { const int tt = t0 + t - 3 + k;
                if (tt >= 0) { const v4u x0 = xq[k][0], x1 = xq[k][1];
                    const LAS float* wp = CW + k * 128 + 16 * cg;
                    const f32x4 w0 = *(const LAS f32x4*)wp, w1 = *(const LAS f32x4*)(wp + 4), w2 = *(const LAS f32x4*)(wp + 8), w3 = *(const LAS f32x4*)(wp + 12);
                    acc4[0] += w0 * (f32x4){bflo(x0.x), bfhi(x0.x), bflo(x0.y), bfhi(x0.y)};
                    acc4[1] += w1 * (f32x4){bflo(x0.z), bfhi(x0.z), bflo(x0.w), bfhi(x0.w)};
                    acc4[2] += w2 * (f32x4){bflo(x1.x), bfhi(x1.x), bflo(x1.y), bfhi(x1.y)};
                    acc4[3] += w3 * (f32x4){bflo(x1.z), bfhi(x1.z), bflo(x1.w), bfhi(x1.w)}; } }
#pragma unroll
            for (int i = 0; i < 4; ++i) *(LAS f32x4*)(XCF + t * 132 + 16 * cg + 4 * i) = acc4[i];
            v4u b0, b1; b0.x = pk2(acc4[0][0], acc4[0][1]); b0.y = pk2(acc4[0][2], acc4[0][3]); b0.z = pk2(acc4[1][0], acc4[1][1]); b0.w = pk2(acc4[1][2], acc4[1][3]);
            b1.x = pk2(acc4[2][0], acc4[2][1]); b1.y = pk2(acc4[2][2], acc4[2][3]); b1.z = pk2(acc4[3][0], acc4[3][1]); b1.w = pk2(acc4[3][2], acc4[3][3]);
            *(LAS v4u*)(XCB + t * RS_QK + 32 * cg) = b0; *(LAS v4u*)(XCB + t * RS_QK + 32 * cg + 16) = b1;
        }
        __syncthreads();
        {
            f32x4 ga[2][2], gx[2][2];
#pragma unroll
            for (int m = 0; m < 2; ++m)
#pragma unroll
                for (int n = 0; n < 2; ++n) { ga[m][n] = (f32x4){0.f, 0.f, 0.f, 0.f}; gx[m][n] = (f32x4){0.f, 0.f, 0.f, 0.f}; }
#pragma unroll
            for (int ks = 0; ks < 4; ++ks) {
                bf16x8 av[2];
#pragma unroll
                for (int m = 0; m < 2; ++m) av[m] = lds_rowfrag(XCB, RS_QK, 32 * wt + 16 * m + l15, 32 * ks + 8 * g);
#pragma unroll
                for (int m = 0; m < 2; ++m)
#pragma unroll
                    for (int n = 0; n < 2; ++n) { ga[m][n] = MFMA16(av[m], fba[ks][n], ga[m][n]); gx[m][n] = MFMA16(av[m], fbx[ks][n], gx[m][n]); }
            }
#pragma unroll
            for (int m = 0; m < 2; ++m)
#pragma unroll
                for (int r = 0; r < 4; ++r) { const int t = 32 * wt + 16 * m + 4 * g + r; const bool rst = posv[m][r] == 0;
#pragma unroll
                    for (int n = 0; n < 2; ++n) { const int d = 32 * wd + 16 * n + l15;
                        const float gr = __builtin_amdgcn_rcpf(1.0f + __builtin_amdgcn_exp2f(__builtin_fmaf(ga[m][n][r], -1.4426950408889634f, bav[n])));
                        const float gi = __builtin_amdgcn_rcpf(1.0f + __builtin_amdgcn_exp2f(__builtin_fmaf(gx[m][n][r], -1.4426950408889634f, bxv[n])));
                        float la = gr * spv[n];
                        if (rst) la = -200.0f;
                        la = __builtin_bit_cast(float, cvt_pk_nv(la, 0.f) << 16);
                        const float av_ = __builtin_amdgcn_exp2f(la);
                        const float mult = __builtin_amdgcn_sqrtf(__builtin_fmaf(-av_, av_, 1.0f));
                        AF[t * 132 + d] = av_; ABW[t * 132 + d] = cvt_pk_nv(la, XCF[t * 132 + d] * gi * mult); } }
        }
        __syncthreads();
        {
            float A = 1.f, B = 0.f; unsigned wv[16];
#pragma unroll
            for (int k = 0; k < 16; ++k) { const int t = 16 * sseg + k; const float av_ = AF[t * 132 + sd]; wv[k] = ABW[t * 132 + sd]; B = av_ * B + __builtin_bit_cast(float, wv[k] & 0xffff0000u); A *= av_; }
#pragma unroll
            for (int j = 0; j < 4; ++j) labo[(size_t)(tl * 4 + j) * NTHR] = (v4u){wv[4 * j], wv[4 * j + 1], wv[4 * j + 2], wv[4 * j + 3]};
            SEG[(sseg * 128 + sd) * 2] = A; SEG[(sseg * 128 + sd) * 2 + 1] = B;
            __syncthreads();
            if (sseg == 3) { float h = 0.f, Ap = 1.f;
#pragma unroll
                for (int s = 0; s < 3; ++s) { const float sa = SEG[(s * 128 + sd) * 2], sb = SEG[(s * 128 + sd) * 2 + 1]; h = sa * h + sb; Ap *= sa; }
                const float At = Ap * A, Bt = A * h + B; Bstrip = At * Bstrip + Bt; Astrip *= At; }
        }
#pragma unroll
        for (int k = 0; k < 4; ++k) { xq[k][0] = xn[k][0]; xq[k][1] = xn[k][1]; }
        __syncthreads();
    }
    if (sseg == 3) { WSP(float, WS_AGGA)[(size_t)sg * 1024 + c0 + sd] = Astrip; WSP(float, WS_AGGB)[(size_t)sg * 1024 + c0 + sd] = Bstrip; }
}
__device__ __forceinline__ void lru_final(const Frame& F0, int sg, int nb) {
    PH_BEGIN; const Frame F = frame_local(F0);
    const int tid = F.tid, c0 = nb * 128, sd = tid & 127, sseg = tid >> 7;
    LAS float* SEG = (LAS float*)(F.lds + L_SEG);
    LAS float* CAR = (LAS float*)(F.lds + L_SEG + 8192);
    bf16* yr = WSP(bf16, WS_Z + 4 * ZSTRIDE) + (size_t)(sg * 512 + 16 * sseg) * 1024 + c0 + sd;
    const v4u* labi = LRU_LAB(sg * 8 + nb) + tid;
    if (tid < 128) CAR[tid] = WSP(float, WS_HIN)[(size_t)sg * 1024 + c0 + tid];
    v4u cw[4]; bf16 yv[16];
#pragma unroll
    for (int j = 0; j < 4; ++j) cw[j] = labi[(size_t)j * NTHR];
#pragma unroll
    for (int k = 0; k < 16; ++k) yv[k] = yr[(size_t)k * 1024];
#pragma unroll 1
    for (int tl = 0; tl < 8; ++tl) {
        const int par = tl & 1, tn = min(tl + 1, 7);
        v4u nw[4]; bf16 yn[16];
#pragma unroll
        for (int j = 0; j < 4; ++j) nw[j] = labi[(size_t)(tn * 4 + j) * NTHR];
#pragma unroll
        for (int k = 0; k < 16; ++k) yn[k] = yr[(size_t)(tn * 64 + k) * 1024];
        float a_[16], b_[16]; float A = 1.f, B = 0.f;
#pragma unroll
        for (int k = 0; k < 16; ++k) { const unsigned w = cw[k >> 2][k & 3];
            a_[k] = __builtin_amdgcn_exp2f(__builtin_bit_cast(float, w << 16)); b_[k] = __builtin_bit_cast(float, w & 0xffff0000u); B = a_[k] * B + b_[k]; A *= a_[k]; }
        SEG[((par * 4 + sseg) * 128 + sd) * 2] = A; SEG[((par * 4 + sseg) * 128 + sd) * 2 + 1] = B;
        __syncthreads();
        float h = CAR[par * 128 + sd];
#pragma unroll
        for (int s = 0; s < 3; ++s) if (s < sseg) { const float sa = SEG[((par * 4 + s) * 128 + sd) * 2], sb = SEG[((par * 4 + s) * 128 + sd) * 2 + 1]; h = sa * h + sb; }
#pragma unroll
        for (int k = 0; k < 16; ++k) { h = a_[k] * h + b_[k]; yr[(size_t)(tl * 64 + k) * 1024] = (bf16)f2bf(h * gelu_tanh_fast(bf2f(yv[k]))); }
        if (sseg == 3) CAR[(par ^ 1) * 128 + sd] = h;
#pragma unroll
        for (int j = 0; j < 4; ++j) cw[j] = nw[j];
#pragma unroll
        for (int k = 0; k < 16; ++k) yv[k] = yn[k];
    }
    __syncthreads();
}
__device__ __forceinline__ void lru_carry(const Frame& F0) {
    PH_BEGIN; const Frame F = frame_local(F0);
    const int gw = blockIdx.x * NWAVES + F.wave, nw = F.G * NWAVES;
    for (int pr = gw; pr < 512; pr += nw) {
        const int ch = 2 * pr + (F.lane >> 5), s = F.lane & 31;
        float a = WSP(float, WS_AGGA)[(size_t)s * 1024 + ch], b = WSP(float, WS_AGGB)[(size_t)s * 1024 + ch];
#pragma unroll
        for (int d = 1; d < 32; d <<= 1) { const float ap = __shfl_up(a, d, 32), bp = __shfl_up(b, d, 32); if (s >= d) { b = a * bp + b; a = a * ap; } }
        const float hin = __shfl_up(b, 1, 32);
        WSP(float, WS_HIN)[(size_t)s * 1024 + ch] = (s == 0) ? 0.f : hin;
    }
}

__device__ __forceinline__ unsigned ordkey(float x) { const unsigned u = __builtin_bit_cast(unsigned, x); return (u & 0x80000000u) ? ~u : (u | 0x80000000u); }
__device__ __forceinline__ void sort16_desc(unsigned (&a)[16]) {
#define S16_CE(i, j) { const unsigned hi_ = max(a[i], a[j]), lo_ = min(a[i], a[j]); a[i] = hi_; a[j] = lo_; }
    S16_CE(0, 13) S16_CE(1, 12) S16_CE(2, 15) S16_CE(3, 14) S16_CE(4, 8) S16_CE(5, 6) S16_CE(7, 11) S16_CE(9, 10)
    S16_CE(0, 5) S16_CE(1, 7) S16_CE(2, 9) S16_CE(3, 4) S16_CE(6, 13) S16_CE(8, 14) S16_CE(10, 15) S16_CE(11, 12)
    S16_CE(0, 1) S16_CE(2, 3) S16_CE(4, 5) S16_CE(6, 8) S16_CE(7, 9) S16_CE(10, 11) S16_CE(12, 13) S16_CE(14, 15)
    S16_CE(0, 2) S16_CE(1, 3) S16_CE(4, 10) S16_CE(5, 11) S16_CE(6, 7) S16_CE(8, 9) S16_CE(12, 14) S16_CE(13, 15)
    S16_CE(1, 2) S16_CE(3, 12) S16_CE(4, 6) S16_CE(5, 7) S16_CE(8, 10) S16_CE(9, 11) S16_CE(13, 14)
    S16_CE(1, 4) S16_CE(2, 6) S16_CE(5, 8) S16_CE(7, 10) S16_CE(9, 13) S16_CE(11, 14)
    S16_CE(2, 4) S16_CE(3, 6) S16_CE(9, 12) S16_CE(11, 13)
    S16_CE(3, 5) S16_CE(6, 8) S16_CE(7, 9) S16_CE(10, 12)
    S16_CE(3, 4) S16_CE(5, 6) S16_CE(7, 8) S16_CE(9, 10) S16_CE(11, 12)
    S16_CE(6, 7) S16_CE(8, 9)
#undef S16_CE
}
__device__ __forceinline__ void merge_top16(unsigned (&a)[16], const unsigned (&b)[16]) {
#pragma unroll
    for (int i = 0; i < 16; ++i) a[i] = max(a[i], b[15 - i]);
#pragma unroll
    for (int lj = 3; lj >= 0; --lj)
#pragma unroll
        for (int i = 0; i < 16; ++i) { const int j = 1 << lj, l = i ^ j;
            if (l > i) { const unsigned hi = max(a[i], a[l]), lo = min(a[i], a[l]); a[i] = hi; a[l] = lo; } }
}
constexpr int TK_SC = 0, TK_KEYS = 132096;
__device__ __forceinline__ void topk_select(LAS unsigned char* ldsb, int tid, int t0, int h, unsigned short* idxb, float* gateb) {
    LAS float* SC = (LAS float*)(ldsb + TK_SC);
    LAS unsigned* KEYS = (LAS unsigned*)(ldsb + TK_KEYS);
    const int row = tid & 255, half = tid >> 8;
    unsigned keys[16];
    {   unsigned k1[16], k2[16], k3[16];
#pragma unroll
        for (int i = 0; i < 16; ++i) { const int n = half * 64 + i;
            keys[i] = (ordkey(SC[row * 129 + n]) & ~127u) | (unsigned)(127 - n); k1[i] = (ordkey(SC[row * 129 + n + 16]) & ~127u) | (unsigned)(127 - n - 16);
            k2[i] = (ordkey(SC[row * 129 + n + 32]) & ~127u) | (unsigned)(127 - n - 32); k3[i] = (ordkey(SC[row * 129 + n + 48]) & ~127u) | (unsigned)(127 - n - 48); }
        sort16_desc(keys); sort16_desc(k1); sort16_desc(k2); sort16_desc(k3);
        merge_top16(keys, k1); merge_top16(k2, k3); merge_top16(keys, k2);
    }
    if (half == 1) {
#pragma unroll
        for (int s = 0; s < 16; ++s) KEYS[s * 256 + row] = keys[s]; }
    __syncthreads();
    float val[16]; int id[16];
    if (half == 0) {
        {   unsigned ko[16];
#pragma unroll
            for (int s2 = 0; s2 < 16; ++s2) ko[s2] = KEYS[s2 * 256 + row];
            merge_top16(keys, ko); }
#pragma unroll
        for (int s = 0; s < 16; ++s) { id[s] = 127 - (int)(keys[s] & 127u); val[s] = SC[row * 129 + id[s]]; }
    }
    __syncthreads();
    if (half == 0) {
#pragma unroll
        for (int s = 0; s < 16; ++s) { SC[row * 129 + s] = val[s]; SC[row * 129 + 16 + s] = __builtin_bit_cast(float, id[s]); }
    }
    __syncthreads();
    if (tid < 128) {
        const LAS float* r1 = SC + tid * 129; const LAS float* r2 = SC + (128 + tid) * 129;
        float v1[16], v2[16];
#pragma unroll
        for (int s = 0; s < 16; ++s) { v1[s] = r1[s]; v2[s] = r2[s]; }
#define CKEY(a_, b_) ((ordkey(v1[a_] + v2[b_]) & ~255u) | (unsigned)(255 - ((a_) * 16 + (b_))))
        unsigned ck[16], c1[16], c2[16], c3[16];
#pragma unroll
        for (int b_ = 0; b_ < 16; ++b_) ck[b_] = CKEY(0, b_);
#pragma unroll
        for (int b_ = 0; b_ < 8; ++b_) c1[b_] = CKEY(1, b_);
#pragma unroll
        for (int b_ = 0; b_ < 5; ++b_) c1[8 + b_] = CKEY(2, b_);
        c1[13] = CKEY(5, 0); c1[14] = CKEY(5, 1); c1[15] = 0u;
#pragma unroll
        for (int b_ = 0; b_ < 4; ++b_) c2[b_] = CKEY(3, b_);
#pragma unroll
        for (int b_ = 0; b_ < 3; ++b_) c2[4 + b_] = CKEY(4, b_);
        c2[7] = CKEY(6, 0); c2[8] = CKEY(6, 1); c2[9] = CKEY(7, 0); c2[10] = CKEY(7, 1);
        c2[11] = CKEY(8, 0); c2[12] = CKEY(9, 0); c2[13] = CKEY(10, 0); c2[14] = CKEY(11, 0); c2[15] = CKEY(12, 0);
        c3[0] = CKEY(13, 0); c3[1] = CKEY(14, 0); c3[2] = CKEY(15, 0);
#pragma unroll
        for (int s = 3; s < 16; ++s) c3[s] = 0u;
#undef CKEY
        sort16_desc(ck); sort16_desc(c1); sort16_desc(c2); sort16_desc(c3);
        merge_top16(ck, c1); merge_top16(c2, c3); merge_top16(ck, c2);
        float vv[16]; int ex[16]; float mx = -3.0e38f;
#pragma unroll
        for (int s = 0; s < 16; ++s) { const int code = 255 - (int)(ck[s] & 255u), a_ = code >> 4, b_ = code & 15;
            vv[s] = r1[a_] + r2[b_]; ex[s] = __builtin_bit_cast(int, r1[16 + a_]) * 128 + __builtin_bit_cast(int, r2[16 + b_]); mx = fmaxf(mx, vv[s]); }
        float sm = 0.f;
#pragma unroll
        for (int s = 0; s < 16; ++s) { vv[s] = __expf(vv[s] - mx); sm += vv[s]; }
        const float inv = 1.0f / sm;
        unsigned short* ip = idxb + (size_t)(t0 + tid) * 128 + h * 16; float* gp = gateb + (size_t)(t0 + tid) * 128 + h * 16;
#pragma unroll
        for (int s8 = 0; s8 < 2; ++s8) *(v4u*)(ip + 8 * s8) = (v4u){(unsigned)ex[8 * s8] | ((unsigned)ex[8 * s8 + 1] << 16), (unsigned)ex[8 * s8 + 2] | ((unsigned)ex[8 * s8 + 3] << 16), (unsigned)ex[8 * s8 + 4] | ((unsigned)ex[8 * s8 + 5] << 16), (unsigned)ex[8 * s8 + 6] | ((unsigned)ex[8 * s8 + 7] << 16)};
#pragma unroll
        for (int s4 = 0; s4 < 4; ++s4) *(f32x4*)(gp + 4 * s4) = (f32x4){vv[4 * s4] * inv, vv[4 * s4 + 1] * inv, vv[4 * s4 + 2] * inv, vv[4 * s4 + 3] * inv};
    }
    __syncthreads();
}

__device__ __forceinline__ void mx_fold_unit(const Frame& F0, int l, int h, int mb, int cb) {
    PH_BEGIN; const Frame F = frame_local(F0);
    const int wid = F.wave, lane = F.lane, g = lane >> 4, l15 = lane & 15, wn = wid >> 2, wc = wid & 3;
    const bf16* km = WSP(bf16, WS_KMEM) + (size_t)(128 * mb + 64 * wn + l15) * 1024 + h * 256 + 8 * g;
    const float* wq = INP(I_WXQ) + (size_t)l * D * D + (size_t)(128 * cb + 32 * wc + l15) * D + h * 256 + 8 * g;
    float gxv[2];
#pragma unroll
    for (int n = 0; n < 2; ++n) gxv[n] = INP(I_GX)[l * D + 128 * cb + 32 * wc + 16 * n + l15];
    f32x4 acc[4][2];
#pragma unroll
    for (int m = 0; m < 4; ++m) { acc[m][0] = (f32x4){0.f, 0.f, 0.f, 0.f}; acc[m][1] = (f32x4){0.f, 0.f, 0.f, 0.f}; }
#pragma unroll 1
    for (int kg = 0; kg < 8; kg += 4) {
        bf16x8 av[4][4]; f32x4 wa[4][2], wb[4][2];
#pragma unroll
        for (int k4 = 0; k4 < 4; ++k4) {
#pragma unroll
            for (int m = 0; m < 4; ++m) av[k4][m] = *(const bf16x8*)(km + (size_t)m * 16 * 1024 + 32 * (kg + k4));
#pragma unroll
            for (int n = 0; n < 2; ++n) { const f32x4* p = (const f32x4*)(wq + (size_t)n * 16 * D + 32 * (kg + k4)); wa[k4][n] = p[0]; wb[k4][n] = p[1]; } }
#pragma unroll
        for (int k4 = 0; k4 < 4; ++k4) { KEEP4(av[k4][0], av[k4][1], av[k4][2], av[k4][3]); KEEP4(wa[k4][0], wa[k4][1], wb[k4][0], wb[k4][1]); }
#pragma unroll
        for (int k4 = 0; k4 < 4; ++k4) { bf16x8 bv[2];
#pragma unroll
            for (int n = 0; n < 2; ++n) { const f32x4 a = wa[k4][n], b = wb[k4][n]; v4u w; w.x = pk2(a.x, a.y); w.y = pk2(a.z, a.w); w.z = pk2(b.x, b.y); w.w = pk2(b.z, b.w); bv[n] = __builtin_bit_cast(bf16x8, w); }
#pragma unroll
            for (int m = 0; m < 4; ++m)
#pragma unroll
                for (int n = 0; n < 2; ++n) acc[m][n] = MFMA16(av[k4][m], bv[n], acc[m][n]); }
    }
    bf16* o = WSP(bf16, WS_WXQ) + (size_t)(h * 256 + 128 * mb) * 1024 + 128 * cb;
#pragma unroll
    for (int m = 0; m < 4; ++m)
#pragma unroll
        for (int n = 0; n < 2; ++n)
#pragma unroll
            for (int r = 0; r < 4; ++r) o[(size_t)(64 * wn + 16 * m + 4 * g + r) * 1024 + 32 * wc + 16 * n + l15] = (bf16)f2bf(acc[m][n][r] * gxv[n]);
}
__device__ __forceinline__ void vo_fold_unit(const Frame& F0, int h, int cb, int mb) {
    PH_BEGIN; const Frame F = frame_local(F0);
    const int wid = F.wave, lane = F.lane, g = lane >> 4, l15 = lane & 15, wn = wid >> 2, wc = wid & 3;
    const bf16* wo = WSP(bf16, WS_WXO) + (size_t)(128 * cb + 64 * wn + l15) * 1024 + h * 256 + 8 * g;
    const bf16* vm = WSP(bf16, WS_VMEMT) + (size_t)(128 * mb + 32 * wc + l15) * 1024 + h * 256 + 8 * g;
    f32x4 acc[4][2];
#pragma unroll
    for (int m = 0; m < 4; ++m) { acc[m][0] = (f32x4){0.f, 0.f, 0.f, 0.f}; acc[m][1] = (f32x4){0.f, 0.f, 0.f, 0.f}; }
#pragma unroll 1
    for (int kg = 0; kg < 8; kg += 4) {
        bf16x8 av[4][4], bv[4][2];
#pragma unroll
        for (int k4 = 0; k4 < 4; ++k4) {
#pragma unroll
            for (int m = 0; m < 4; ++m) av[k4][m] = *(const bf16x8*)(wo + (size_t)m * 16 * 1024 + 32 * (kg + k4));
#pragma unroll
            for (int n = 0; n < 2; ++n) bv[k4][n] = *(const bf16x8*)(vm + (size_t)n * 16 * 1024 + 32 * (kg + k4)); }
#pragma unroll
        for (int k4 = 0; k4 < 4; ++k4) { KEEP4(av[k4][0], av[k4][1], av[k4][2], av[k4][3]); KEEP2(bv[k4][0], bv[k4][1]); }
#pragma unroll
        for (int k4 = 0; k4 < 4; ++k4)
#pragma unroll
            for (int m = 0; m < 4; ++m)
#pragma unroll
                for (int n = 0; n < 2; ++n) acc[m][n] = MFMA16(av[k4][m], bv[k4][n], acc[m][n]);
    }
    bf16* o = WSP(bf16, WS_WXV) + (size_t)(128 * cb) * 1024 + h * 256 + 128 * mb;
#pragma unroll
    for (int m = 0; m < 4; ++m)
#pragma unroll
        for (int n = 0; n < 2; ++n)
#pragma unroll
            for (int r = 0; r < 4; ++r) o[(size_t)(64 * wn + 16 * m + 4 * g + r) * 1024 + 32 * wc + 16 * n + l15] = (bf16)f2bf(acc[m][n][r]);
}
__device__ __forceinline__ void memkv_block(const Frame& F0, int u) {
    PH_BEGIN; const Frame F = frame_local(F0);
    const int wid = F.wave, lane = F.lane, g = lane >> 4, l15 = lane & 15, wm = wid >> 1, wn = wid & 1;
    const int which = u >> 7, mb = (u >> 5) & 3, nb = u & 31;
    const bf16* ap = WSP(bf16, WS_MEMN) + (size_t)(64 * mb + 16 * wm + l15) * 1024 + 8 * g;
    const bf16* bp = WSP(bf16, which ? WS_WXV : WS_WXK) + (size_t)(32 * nb + 16 * wn + l15) * 1024 + 8 * g;
    f32x4 acc0 = {0.f, 0.f, 0.f, 0.f}, acc1 = {0.f, 0.f, 0.f, 0.f};
#pragma unroll 1
    for (int kb = 0; kb < 32; kb += 8) {
        bf16x8 av[8], bv[8];
#pragma unroll
        for (int j = 0; j < 8; ++j) { av[j] = *(const bf16x8*)(ap + 32 * (kb + j)); bv[j] = *(const bf16x8*)(bp + 32 * (kb + j)); }
        KEEP8(av); KEEP8(bv);
#pragma unroll
        for (int j = 0; j < 8; j += 2) { acc0 = MFMA16(av[j], bv[j], acc0); acc1 = MFMA16(av[j + 1], bv[j + 1], acc1); }
    }
    bf16* o = WSP(bf16, which ? WS_VMEMT : WS_KMEM) + (size_t)(64 * mb + 16 * wm + 4 * g) * 1024 + 32 * nb + 16 * wn + l15;
#pragma unroll
    for (int r = 0; r < 4; ++r) o[(size_t)r * 1024] = (bf16)f2bf(acc0[r] + acc1[r]);
}
struct EpiSoftmax {
    static constexpr bool PERM = true, AFTER_DRAIN = true;
    const ss_t* ss; bf16* P;
    __device__ __forceinline__ void fused(f32x4 (&acc)[2][2][4][2], const pg8::Unit& u, int wr, int wc, int fr, int fq, LAS unsigned char* ldsb, int wid, int lane) const {
        LAS float* RED = (LAS float*)ldsb;
        float mloc[2][4]; ss_t ssv[8];
#pragma unroll
        for (int i = 0; i < 8; ++i) ssv[i] = ss[u.pm * 256 + (i >> 2) * 128 + wr * 64 + (i & 3) * 16 + fr];
        KEEP8(ssv);
#pragma unroll
        for (int ai = 0; ai < 2; ++ai)
#pragma unroll
            for (int m = 0; m < 4; ++m) { const int row = ai * 128 + wr * 64 + m * 16 + fr;
                const float rsc = __builtin_amdgcn_rsqf(ss_flt(ssv[ai * 4 + m]) * (1.0f / 1024.0f) + EPS) * 0.09016844005556021f;
                float mx = -3.0e38f;
#pragma unroll
                for (int bj = 0; bj < 2; ++bj)
#pragma unroll
                    for (int n = 0; n < 2; ++n) { acc[ai][bj][m][n] = acc[ai][bj][m][n] * rsc; const f32x4 v = acc[ai][bj][m][n]; mx = fmaxf(fmaxf(mx, fmaxf(v[0], v[1])), fmaxf(v[2], v[3])); }
                mx = cross_row_max(mx);
                float sm = 0.f;
#pragma unroll
                for (int bj = 0; bj < 2; ++bj)
#pragma unroll
                    for (int n = 0; n < 2; ++n)
#pragma unroll
                        for (int j = 0; j < 4; ++j) { const float pv = __builtin_amdgcn_exp2f(acc[ai][bj][m][n][j] - mx); acc[ai][bj][m][n][j] = pv; sm += pv; }
                sm = cross_row_sum(sm);
                mloc[ai][m] = mx;
                if (fq == 0) { RED[(row * 4 + wc) * 2] = mx; RED[(row * 4 + wc) * 2 + 1] = sm; } }
        __syncthreads();
#pragma unroll
        for (int ai = 0; ai < 2; ++ai)
#pragma unroll
            for (int m = 0; m < 4; ++m) { const int row = ai * 128 + wr * 64 + m * 16 + fr;
                const f32x4 ra = *(const LAS f32x4*)(RED + row * 8), rb = *(const LAS f32x4*)(RED + row * 8 + 4);
                const float M = fmaxf(fmaxf(ra[0], ra[2]), fmaxf(rb[0], rb[2]));
                const float L = ra[1] * __builtin_amdgcn_exp2f(ra[0] - M) + ra[3] * __builtin_amdgcn_exp2f(ra[2] - M) + rb[1] * __builtin_amdgcn_exp2f(rb[0] - M) + rb[3] * __builtin_amdgcn_exp2f(rb[2] - M);
                const float f = __builtin_amdgcn_exp2f(mloc[ai][m] - M) * __builtin_amdgcn_rcpf(L);
                bf16* prow = P + (size_t)(u.pm * 256 + row) * 1024 + u.pn * 256 + wc * 32 + 8 * fq;
#pragma unroll
                for (int bj = 0; bj < 2; ++bj) { const f32x4 v0 = acc[ai][bj][m][0] * f, v1 = acc[ai][bj][m][1] * f; v4u w; w.x = pk2(v0[0], v0[1]); w.y = pk2(v0[2], v0[3]); w.z = pk2(v1[0], v1[1]); w.w = pk2(v1[2], v1[3]); *(v4u*)(prow + bj * 128) = w; } }
        __syncthreads();
    }
};
struct EpiTopk {
    static constexpr bool PERM = false, AFTER_DRAIN = true;
    const ss_t* ss; unsigned short* idx; float* gate; int head0;
    __device__ __forceinline__ void fused(f32x4 (&acc)[2][2][4][2], const pg8::Unit& u, int wr, int wc, int fr, int fq, LAS unsigned char* ldsb, int wid, int lane) const {
        LAS float* SC = (LAS float*)(ldsb + TK_SC);
        const int tid = wid * 64 + lane;
        ss_t ssv[2][4];
#pragma unroll
        for (int ai = 0; ai < 2; ++ai)
#pragma unroll
            for (int m = 0; m < 4; ++m) ssv[ai][m] = ss[u.pm * 256 + ai * 128 + wr * 64 + m * 16 + fr];
        KEEP4(ssv[0][0], ssv[0][1], ssv[0][2], ssv[0][3]); KEEP4(ssv[1][0], ssv[1][1], ssv[1][2], ssv[1][3]);
#pragma unroll
        for (int ai = 0; ai < 2; ++ai) {
            const int t0 = u.pm * 256 + ai * 128;
#pragma unroll
            for (int m = 0; m < 4; ++m) { const int row = wr * 64 + m * 16 + fr; const float rsc = __builtin_amdgcn_rsqf(ss_flt(ssv[ai][m]) * (1.0f / 1024.0f) + EPS);
#pragma unroll
                for (int bj = 0; bj < 2; ++bj)
#pragma unroll
                    for (int n = 0; n < 2; ++n) { const f32x4 v = acc[ai][bj][m][n] * rsc; LAS float* p = SC + (bj * 128 + row) * 129 + wc * 32 + n * 16 + 4 * fq;
                        p[0] = v[0]; p[1] = v[1]; p[2] = v[2]; p[3] = v[3]; } }
            __syncthreads();
            topk_select(ldsb, tid, t0, head0 + u.pn, idx, gate);
        }
    }
};
__device__ __forceinline__ void pq_fold_unit(const Frame& F0, int l, int hs, int cb) {
    PH_BEGIN; const Frame F = frame_local(F0);
    const int wid = F.wave, lane = F.lane, g = lane >> 4, l15 = lane & 15;
    const int wn = wid >> 2, wc = wid & 3, h = hs >> 1, side = hs & 1;
    const float* sk = INP(side ? I_SK2 : I_SK1) + (size_t)l * 8 * 128 * 128 + (size_t)h * 128 * 128;
    const float* wq = INP(I_WPQ) + (size_t)l * D * PQC + h * 256 + side * 128;
    float gfv[2];
#pragma unroll
    for (int n = 0; n < 2; ++n) gfv[n] = INP(I_GFFN)[l * D + 128 * cb + 32 * wc + 16 * n + l15];
    f32x4 acc[4][2];
#pragma unroll
    for (int m = 0; m < 4; ++m) { acc[m][0] = (f32x4){0.f, 0.f, 0.f, 0.f}; acc[m][1] = (f32x4){0.f, 0.f, 0.f, 0.f}; }
#pragma unroll 1
    for (int kg = 0; kg < 4; kg += 2) {
        f32x4 sa[2][4], sb[2][4], wa[2][2], wb[2][2];
#pragma unroll
        for (int k2 = 0; k2 < 2; ++k2) {
#pragma unroll
            for (int m = 0; m < 4; ++m) { const f32x4* p = (const f32x4*)(sk + (size_t)(64 * wn + 16 * m + l15) * 128 + 32 * (kg + k2) + 8 * g); sa[k2][m] = p[0]; sb[k2][m] = p[1]; }
#pragma unroll
            for (int n = 0; n < 2; ++n) { const f32x4* p = (const f32x4*)(wq + (size_t)(128 * cb + 32 * wc + 16 * n + l15) * PQC + 32 * (kg + k2) + 8 * g); wa[k2][n] = p[0]; wb[k2][n] = p[1]; } }
#pragma unroll
        for (int k2 = 0; k2 < 2; ++k2) { KEEP4(sa[k2][0], sa[k2][1], sa[k2][2], sa[k2][3]); KEEP4(sb[k2][0], sb[k2][1], sb[k2][2], sb[k2][3]); KEEP4(wa[k2][0], wa[k2][1], wb[k2][0], wb[k2][1]); }
#pragma unroll
        for (int k2 = 0; k2 < 2; ++k2) { bf16x8 av[4], bv[2];
#pragma unroll
            for (int m = 0; m < 4; ++m) { const f32x4 a = sa[k2][m], b = sb[k2][m]; v4u w; w.x = pk2(a.x, a.y); w.y = pk2(a.z, a.w); w.z = pk2(b.x, b.y); w.w = pk2(b.z, b.w); av[m] = __builtin_bit_cast(bf16x8, w); }
#pragma unroll
            for (int n = 0; n < 2; ++n) { const f32x4 a = wa[k2][n], b = wb[k2][n]; v4u w; w.x = pk2(a.x, a.y); w.y = pk2(a.z, a.w); w.z = pk2(b.x, b.y); w.w = pk2(b.z, b.w); bv[n] = __builtin_bit_cast(bf16x8, w); }
#pragma unroll
            for (int m = 0; m < 4; ++m)
#pragma unroll
                for (int n = 0; n < 2; ++n) acc[m][n] = MFMA16(av[m], bv[n], acc[m][n]); }
    }
    bf16* mt = WSP(bf16, WS_WPQ) + (size_t)hs * 128 * 1024;
#pragma unroll
    for (int m = 0; m < 4; ++m)
#pragma unroll
        for (int n = 0; n < 2; ++n)
#pragma unroll
            for (int r = 0; r < 4; ++r) mt[(size_t)(64 * wn + 16 * m + 4 * g + r) * 1024 + 128 * cb + 32 * wc + 16 * n + l15] = (bf16)f2bf(acc[m][n][r] * gfv[n]);
}
typedef float f32x2 __attribute__((ext_vector_type(2)));
template <int CTRL> __device__ __forceinline__ int dppi(int x) { return __builtin_amdgcn_mov_dpp(x, CTRL, 0xf, 0xf, true); }
typedef int pu_v4i_t __attribute__((ext_vector_type(4)));
typedef float pvf2_t __attribute__((ext_vector_type(2)));
#define PU_LOAD_R(t_, R) do { const v4u* ip_ = (const v4u*)(WSP(unsigned short, WS_IDX) + (size_t)(t_) * 128 + 16 * grp); _Pragma("unroll") for (int q_ = 0; q_ < 2; ++q_) { const v4u v_ = ip_[q_]; _Pragma("unroll") for (int j_ = 0; j_ < 4; ++j_) { R[8 * q_ + 2 * j_] = (int)(v_[j_] & 0xffffu); R[8 * q_ + 2 * j_ + 1] = (int)(v_[j_] >> 16); } } } while (0)
#define PU_ISSUE(t_, Q, R, HX) do { _Pragma("unroll") for (int b_ = 0; b_ < 16; ++b_) Q[b_] = *(const v4u*)(PUx + (size_t)(unsigned)((R[b_] << 7) + 16 * sub)); \
        const v4u* xr_ = (const v4u*)(WSP(bf16, WS_XN) + (size_t)(t_) * 1024 + 128 * x + 16 * sub); HX[0] = xr_[0]; HX[1] = xr_[1]; } while (0)
#define PU_COMPUTE(t_, Q, HX) do { float h_[16]; float am_ = 0.f; \
        _Pragma("unroll") for (int j_ = 0; j_ < 2; ++j_) _Pragma("unroll") for (int w_ = 0; w_ < 4; ++w_) { const unsigned u_ = HX[j_][w_]; h_[8 * j_ + 2 * w_] = bflo(u_); h_[8 * j_ + 2 * w_ + 1] = bfhi(u_); \
            am_ = fmaxf(am_, fmaxf(fabsf(h_[8 * j_ + 2 * w_]), fabsf(h_[8 * j_ + 2 * w_ + 1]))); } \
        am_ = fmaxf(am_, dppf<0xB1>(am_)); am_ = fmaxf(am_, dppf<0x4E>(am_)); am_ = fmaxf(am_, dppf<0x141>(am_));          \
        const float sc_ = am_ > 0.f ? 127.0f / am_ : 0.f, inv_ = am_ * (1.0f / 127.0f); \
        int hq_[4]; \
        _Pragma("unroll") for (int w_ = 0; w_ < 4; ++w_) hq_[w_] = (int)pack_i8x4(h_[4 * w_] * sc_, h_[4 * w_ + 1] * sc_, h_[4 * w_ + 2] * sc_, h_[4 * w_ + 3] * sc_); \
        int res_[16]; \
        _Pragma("unroll") for (int b_ = 0; b_ < 16; ++b_) { int a_ = 0; \
            _Pragma("unroll") for (int w_ = 0; w_ < 4; ++w_) { const unsigned qw_ = Q[b_][w_]; a_ = __builtin_amdgcn_sdot4((int)qw_, hq_[w_], a_, false); } \
            a_ += dppi<0xB1>(a_); a_ += dppi<0x4E>(a_); a_ += dppi<0x141>(a_); res_[b_] = a_; }                                   \
        int v0_ = res_[0], v1_ = res_[1]; \
        _Pragma("unroll") for (int s_ = 1; s_ < 8; ++s_) { v0_ = (sub == s_) ? res_[2 * s_] : v0_; v1_ = (sub == s_) ? res_[2 * s_ + 1] : v1_; } \
        sraw[(size_t)(t_) * 64 + lane] = pk2((float)v0_ * inv_, (float)v1_ * inv_); } while (0)
#define PU_LOAD_RAW(t_, RAW) do { RAW = WSP(unsigned, WS_IDX)[(size_t)(t_) * 64 + lane]; } while (0)
#define PU_STAGE_R(RAW, R, SLOT) do { *(LAS unsigned*)((SLOT) + 4 * lane) = RAW; \
        _Pragma("unroll") for (int q_ = 0; q_ < 2; ++q_) { const v4u v_ = *(const LAS v4u*)((SLOT) + 32 * grp + 16 * q_); _Pragma("unroll") for (int j_ = 0; j_ < 4; ++j_) { R[8 * q_ + 2 * j_] = (int)(v_[j_] & 0xffffu); R[8 * q_ + 2 * j_ + 1] = (int)(v_[j_] >> 16); } } } while (0)
#define PU_ISSUE2(t_, Q, R, HR) do { HR = WSP(unsigned, WS_XN)[(size_t)(t_) * 512 + 64 * x + lane]; \
        _Pragma("unroll") for (int b_ = 0; b_ < 16; ++b_) Q[b_] = *(const v4u*)(PUx + (size_t)(unsigned)((R[b_] << 7) + 16 * sub)); } while (0)
#define PU_COMPUTE2(t_, Q, HR, HSLOT) do { v4u hx_[2]; *(LAS unsigned*)((HSLOT) + 4 * lane) = HR; hx_[0] = *(const LAS v4u*)((HSLOT) + 32 * sub); hx_[1] = *(const LAS v4u*)((HSLOT) + 32 * sub + 16); \
        PU_COMPUTE(t_, Q, hx_); } while (0)
template <bool FAKE>
__device__ __forceinline__ void peer_u_phase(const Frame& F0) {
    PH_BEGIN; const Frame F = frame_local(F0);
    const int lane = F.lane, x = blockIdx.x & 7, grp = lane >> 3, sub = lane & 7;
    const int nwv = ((F.G - x + 7) >> 3) * NWAVES, wv = (blockIdx.x >> 3) * NWAVES + F.wave;
    const unsigned char* PUx = WSP(unsigned char, WS_PU8) + (size_t)x * SLICE_BYTES;
    unsigned* sraw = WSP(unsigned, WS_SRAW) + (size_t)x * T * 64;
    int ri[16]; v4u ha[2], hb[2]; v4u qa[16], qb[16];
    const int ntok = T / nwv;
    if (T % nwv == 0 && (ntok & 1) == 0 && wv < nwv) {
        const int tlast = wv + (ntok - 1) * nwv;
        LAS unsigned char* us_ = F.lds + F.wave * 2048;
        unsigned rawp, rawn, hra, hrb;
        PU_LOAD_R(wv, ri); PU_ISSUE2(wv, qa, ri, hra); PU_LOAD_R(wv + nwv, ri); PU_LOAD_RAW(min(wv + 2 * nwv, tlast), rawp);
#pragma unroll 1
        for (int t = wv; t <= tlast; t += 2 * nwv) {
            const int t2 = min(t + 2 * nwv, tlast), t3 = min(t + 3 * nwv, tlast), t4 = min(t + 4 * nwv, tlast);
            PU_ISSUE2(t + nwv, qb, ri, hrb); PU_LOAD_RAW(t3, rawn); PU_STAGE_R(rawp, ri, us_); PU_COMPUTE2(t, qa, hra, us_ + 512); rawp = rawn;
            PU_ISSUE2(t2, qa, ri, hra); PU_LOAD_RAW(t4, rawn); PU_STAGE_R(rawp, ri, us_ + 256); PU_COMPUTE2(t + nwv, qb, hrb, us_ + 768); rawp = rawn;
        }
    } else {
        for (int t = wv; t < T; t += nwv) { PU_LOAD_R(t, ri); PU_ISSUE(t, qa, ri, ha); PU_COMPUTE(t, qa, ha); }
    }
}
#undef PU_LOAD_R
#undef PU_ISSUE
#undef PU_COMPUTE
#undef PU_LOAD_RAW
#undef PU_STAGE_R
#undef PU_ISSUE2
#undef PU_COMPUTE2
__device__ __forceinline__ void peer_combine(const Frame& F0) {
    PH_BEGIN; const Frame F = frame_local(F0);
    const size_t gt = (size_t)F.vcu * NTHR + F.tid, GN = (size_t)F.G * NTHR;
    for (size_t g8 = gt; g8 < (size_t)T * 16; g8 += GN) {
        v4u p[8]; f32x4 ga, gb;
        const v4u ixv = WSP(v4u, WS_IDX)[g8];
#pragma unroll
        for (int x = 0; x < 8; ++x) p[x] = WSP(v4u, WS_SRAW)[(size_t)x * T * 16 + g8];
        ss_t q = WSP(ss_t, WS_SSB)[g8 >> 4]; ga = WSP(f32x4, WS_GATE)[2 * g8]; gb = WSP(f32x4, WS_GATE)[2 * g8 + 1];
        v4u ixk = ixv; KEEP4(ixk.x, ixk.y, ixk.z, ixk.w);
        float uu[8], vv[8];
#pragma unroll
        for (int j = 0; j < 4; ++j) { const unsigned i0 = ixk[j] & 0xffffu, i1 = ixk[j] >> 16; uu[2 * j] = WSP(float, WS_SCU)[i0]; uu[2 * j + 1] = WSP(float, WS_SCU)[i1]; vv[2 * j] = WSP(float, WS_SCV)[i0]; vv[2 * j + 1] = WSP(float, WS_SCV)[i1]; }
        KEEP8(p); KEEP2(ga, gb); KEEP8(uu); KEEP8(vv);
        const float rs = __builtin_amdgcn_rsqf(ss_flt(q) * (1.0f / 1024.0f) + EPS);
        float w[8];
#pragma unroll
        for (int j = 0; j < 4; ++j) {
            const float s0 = ((bflo(p[0][j]) + bflo(p[1][j])) + (bflo(p[2][j]) + bflo(p[3][j]))) + ((bflo(p[4][j]) + bflo(p[5][j])) + (bflo(p[6][j]) + bflo(p[7][j])));
            const float s1 = ((bfhi(p[0][j]) + bfhi(p[1][j])) + (bfhi(p[2][j]) + bfhi(p[3][j]))) + ((bfhi(p[4][j]) + bfhi(p[5][j])) + (bfhi(p[6][j]) + bfhi(p[7][j])));
            const float g0 = (j < 2) ? ga[2 * j] : gb[2 * j - 4], g1 = (j < 2) ? ga[2 * j + 1] : gb[2 * j - 3];
            w[2 * j] = gelu_tanh(s0 * uu[2 * j] * rs) * g0 * vv[2 * j]; w[2 * j + 1] = gelu_tanh(s1 * uu[2 * j + 1] * rs) * g1 * vv[2 * j + 1]; }
        WSP(f32x4, WS_PW)[2 * g8] = (f32x4){w[0], w[1], w[2], w[3]}; WSP(f32x4, WS_PW)[2 * g8 + 1] = (f32x4){w[4], w[5], w[6], w[7]};
    }
}
#define PV_LOAD_R(t_, R) do { const v4u* ip_ = (const v4u*)(WSP(unsigned short, WS_IDX) + (size_t)(t_) * 128 + 16 * grp); _Pragma("unroll") for (int q_ = 0; q_ < 2; ++q_) { const v4u v_ = ip_[q_]; _Pragma("unroll") for (int j_ = 0; j_ < 4; ++j_) { R[8 * q_ + 2 * j_] = (int)(v_[j_] & 0xffffu); R[8 * q_ + 2 * j_ + 1] = (int)(v_[j_] >> 16); } } } while (0)
#define PV_ISSUE(t_, Q, R, WV, XR) do { const f32x4* wp_ = (const f32x4*)(WSP(float, WS_PW) + (size_t)(t_) * 128 + 16 * grp); _Pragma("unroll") for (int q_ = 0; q_ < 4; ++q_) { const f32x4 v_ = wp_[q_]; WV[4 * q_] = v_.x; WV[4 * q_ + 1] = v_.y; WV[4 * q_ + 2] = v_.z; WV[4 * q_ + 3] = v_.w; } \
        XR = *(const unsigned*)(WSP(bf16, WS_XN) + (size_t)(t_) * 1024 + 128 * x + 2 * cpair); \
        _Pragma("unroll") for (int b_ = 0; b_ < 16; ++b_) Q[b_] = *(const v4u*)(PVx + (size_t)(unsigned)((R[b_] << 7) + 16 * sub)); } while (0)
#define PV_COMPUTE(t_, Q, WV, XR) do { \
        pvf2_t ac_[8]; \
        _Pragma("unroll") for (int j_ = 0; j_ < 8; ++j_) ac_[j_] = (pvf2_t){0.f, 0.f}; \
        _Pragma("unroll") for (int b_ = 0; b_ < 16; ++b_) { const pvf2_t w2_ = {WV[b_], WV[b_]}; \
            _Pragma("unroll") for (int w_ = 0; w_ < 4; ++w_) { const int dw_ = (int)Q[b_][w_]; \
                ac_[2 * w_] = __builtin_elementwise_fma(__builtin_amdgcn_cvt_pk_f32_fp8(dw_, false), w2_, ac_[2 * w_]); \
                ac_[2 * w_ + 1] = __builtin_elementwise_fma(__builtin_amdgcn_cvt_pk_f32_fp8(dw_, true), w2_, ac_[2 * w_ + 1]); } } \
          \
          \
        pvf2_t k4_[4]; \
        _Pragma("unroll") for (int i_ = 0; i_ < 4; ++i_) { k4_[i_].x = half_sum32(ac_[i_].x, ac_[4 + i_].x); k4_[i_].y = half_sum32(ac_[i_].y, ac_[4 + i_].y); } \
        pvf2_t k2_[2]; \
        _Pragma("unroll") for (int i_ = 0; i_ < 2; ++i_) { k2_[i_].x = half_sum16(k4_[i_].x, k4_[2 + i_].x); k2_[i_].y = half_sum16(k4_[i_].y, k4_[2 + i_].y); } \
        pvf2_t o_; { const pvf2_t keep_ = b3 ? k2_[1] : k2_[0], send_ = b3 ? k2_[0] : k2_[1]; \
            o_.x = keep_.x + dppf<0x128>(send_.x); o_.y = keep_.y + dppf<0x128>(send_.y); } \
        const unsigned p_ = pk2(bflo(XR) + o_.x, bfhi(XR) + o_.y);                    \
        if (!DRYV || p_ == 0x12345678u) *(unsigned*)(WSP(bf16, WS_XN) + (size_t)(t_) * 1024 + 128 * x + 2 * cpair) = p_; \
        float ss_ = bflo(p_) * bflo(p_) + bfhi(p_) * bfhi(p_); \
        ss_ = wave_sum(ss_); \
        if (lane == 0 && (!DRYV || ss_ == 1.2345e30f)) atomicAdd(WSP(ss_t, WS_SSC) + (size_t)l * T + (t_), ss_fix(ss_)); } while (0)
__device__ __forceinline__ void peer_v_phase(const Frame& F0, int l, bool DRYV) {
    PH_BEGIN; const Frame F = frame_local(F0);
    const int lane = F.lane, x = blockIdx.x & 7, grp = lane >> 3, sub = lane & 7;
    const bool b3 = (lane & 8) != 0, b4 = (lane & 16) != 0, b5 = (lane & 32) != 0;
    const int cpair = 8 * sub + 4 * (int)b5 + 2 * (int)b4 + (int)b3;
    const int nwv = ((F.G - x + 7) >> 3) * NWAVES, wv = (blockIdx.x >> 3) * NWAVES + F.wave;
    const unsigned char* PVx = WSP(unsigned char, WS_PV8) + (size_t)x * SLICE_BYTES;
    int ri[16]; float wa[16], wb[16]; v4u qa[16], qb[16]; unsigned xa, xb;
    const int ntok = T / nwv;
    if (T % nwv == 0 && (ntok & 1) == 0 && wv < nwv) {
        const int tlast = wv + (ntok - 1) * nwv;
        PV_LOAD_R(wv, ri); PV_ISSUE(wv, qa, ri, wa, xa); PV_LOAD_R(wv + nwv, ri);
#pragma unroll 1
        for (int t = wv; t <= tlast; t += 2 * nwv) {
            const int t2 = min(t + 2 * nwv, tlast), t3 = min(t + 3 * nwv, tlast);
            PV_ISSUE(t + nwv, qb, ri, wb, xb); PV_LOAD_R(t2, ri); PV_COMPUTE(t, qa, wa, xa);
            PV_ISSUE(t2, qa, ri, wa, xa);
            PV_LOAD_R(t3, ri); PV_COMPUTE(t + nwv, qb, wb, xb);
        }
    } else {
        for (int t = wv; t < T; t += nwv) { PV_LOAD_R(t, ri); PV_ISSUE(t, qa, ri, wa, xa); PV_COMPUTE(t, qa, wa, xa); }
    }
}
#undef PV_LOAD_R
#undef PV_ISSUE
#undef PV_COMPUTE
__device__ __forceinline__ void final_norm(const Frame& F0) {
    PH_BEGIN; const Frame F = frame_local(F0);
    const size_t gt = (size_t)F.vcu * NTHR + F.tid, GN = (size_t)F.G * NTHR;
    const v2u* xs = WSP(v2u, WS_XN);
    if ((size_t)T * 256 % (4 * GN) == 0 && GN % 256 == 0) {
        const f32x4 gfin = ((const f32x4*)INP(I_GFIN))[gt & 255];
        v2u xv[4]; ss_t rs[4];
#pragma unroll
        for (int i = 0; i < 4; ++i) { xv[i] = xs[gt + i * GN]; rs[i] = WSP(ss_t, WS_SSC)[(size_t)T + ((gt + i * GN) >> 8)]; }
        for (size_t e = gt; e < (size_t)T * 256; e += 4 * GN) {
            const size_t en = (e + 4 * GN < (size_t)T * 256) ? e + 4 * GN : e;
            v2u xn[4]; ss_t rn[4];
#pragma unroll
            for (int i = 0; i < 4; ++i) { xn[i] = xs[en + i * GN]; rn[i] = WSP(ss_t, WS_SSC)[(size_t)T + ((en + i * GN) >> 8)]; }
            KEEP4(xv[0], xv[1], xv[2], xv[3]); KEEP4(rs[0], rs[1], rs[2], rs[3]);
#pragma unroll
            for (int i = 0; i < 4; ++i) { const f32x4 xf = {bflo(xv[i].x), bfhi(xv[i].x), bflo(xv[i].y), bfhi(xv[i].y)};
                ((f32x4*)X_)[e + i * GN] = xf * __builtin_amdgcn_rsqf(ss_flt(rs[i]) * (1.0f / 1024.0f) + EPS) * gfin; }
#pragma unroll
            for (int i = 0; i < 4; ++i) { xv[i] = xn[i]; rs[i] = rn[i]; }
        }
        return;
    }
    for (size_t e = gt; e < (size_t)T * 256; e += GN) { const int t = (int)(e >> 8), c4 = (int)(e & 255);
        const float rs = __builtin_amdgcn_rsqf(ss_flt(WSP(ss_t, WS_SSC)[(size_t)T + t]) * (1.0f / 1024.0f) + EPS);
        const v2u q = xs[e]; const f32x4 xf = {bflo(q.x), bfhi(q.x), bflo(q.y), bfhi(q.y)};
        ((f32x4*)X_)[e] = xf * rs * ((const f32x4*)INP(I_GFIN))[c4]; }
}

#ifndef MK_CODE
#define MK_CODE 0xFFFFFFFFu
#endif
#define CODE(b) ((MK_CODE >> (b)) & 1u)
#ifndef MK_PHASE_MASK
#define MK_PHASE_MASK 0xFFFFFFFFu
#endif
__global__ void __launch_bounds__(NWAVES * 64, 2) mk_fwd(Args args) {
    extern __shared__ __attribute__((aligned(16))) unsigned char lds[];
    Frame F;
    F.lds = (LAS unsigned char*)lds;
    F.tid = threadIdx.x; F.lane = F.tid & 63; F.wave = __builtin_amdgcn_readfirstlane(F.tid >> 6);
    F.G = gridDim.x; { const int bx = blockIdx.x; F.vcu = (F.G % 8 == 0) ? (bx % 8) * (F.G / 8) + bx / 8 : bx; }
    volatile LAS unsigned* MISC = (volatile LAS unsigned*)(F.lds + MISC_OFF);
    for (int u = F.tid; u < (LDS_BYTES - LDSCTL_OFF) / 4; u += NWAVES * 64) ((LAS unsigned*)(F.lds + LDSCTL_OFF))[u] = 0u;
    __syncthreads();
    XcdBarrier bar; { PH_BEGIN; bar = xcd_barrier_post((unsigned*)(ws_ + WS_CTL) + CW_BAR, MISC + 8);
        if (F.tid == 0) (void)__hip_atomic_fetch_or(&bar.bar[XB_XMASK(blockIdx.x & 7u)], 1u << bar.x, __ATOMIC_RELAXED, __HIP_MEMORY_SCOPE_AGENT); }
#ifndef REP_PRO
#define REP_PRO 1
#define REP_G1 1
#define REP_A 1
#define REP_FAKE 0
#define REP_LA 1
#define REP_R3 1
#define REP_LF 1
#define REP_M12 1
#define REP_XQ 1
#define REP_XA 1
#define REP_PQ 1
#define REP_TK 1
#define REP_GA 1
#define REP_NRM 1
#endif
#define GRID_BAR() xcd_barrier(bar)
#ifdef NO_RES_BAR
#define RES_BAR() xcd_barrier(bar)
#else
#define RES_BAR() res_barrier(bar, MISC + 10)
#endif
    const int G = F.G, bid = blockIdx.x;
    LAS unsigned char* ring = F.lds;

#ifdef TR8_TEST
    {
        PH_BEGIN; typedef int v2i_t __attribute__((ext_vector_type(2)));
        if (blockIdx.x == 0 && F.wave == 0) {
            LAS unsigned char* tt = F.lds;
            for (int i = F.lane; i < 64 * 144; i += 64) tt[i] = (unsigned char)((i / 144) * 16 + (i % 144));
            asm volatile("s_waitcnt lgkmcnt(0)" ::: "memory");
            const int g = F.lane >> 4, j = F.lane & 15;
            const v2i_t r = __builtin_amdgcn_ds_read_tr8_b64_v2i32((LAS v2i_t*)(tt + (8 * g + (j >> 1)) * 144 + 8 * (j & 1)));
            const unsigned r0 = (unsigned)r.x, r1 = (unsigned)r.y; int bad = 0;
            for (int e = 0; e < 8; ++e) { const unsigned got = ((e < 4 ? r0 : r1) >> (8 * (e & 3))) & 0xffu; const unsigned want = (unsigned)((8 * g + e) * 16 + j) & 0xffu; bad |= (got != want); }
            if (bad) ((unsigned*)(ws_ + WS_CTL))[2] = 1u;
        }
        __syncthreads();
    }
#endif
    if (CODE(0)) rotary_tables(F);
#pragma unroll 1
    for (int l = 0; l < NLAYER; ++l) {
        for (int rep = 0; rep < REP_PRO; ++rep) if (CODE(0)) { phase_prologue(F, l); for (int u = bid; u < 128; u += G) pq_fold_unit(F, l, u >> 3, u & 7); }
        GRID_BAR();
        if (l == 0 && F.tid == 0) {
            unsigned ok = (G % 8 == 0) ? 1u : 0u;
            for (unsigned j = 0; j < 8; ++j) { const unsigned m = xb_ld(&bar.bar[XB_XMASK(j)]); ok &= (__builtin_popcount(m) == 1) ? 1u : 0u; }
            MISC[10] = ok;
        }
        for (int rep = 0; rep < REP_G1; ++rep) if (CODE(1)) {
            PH_BEGIN; pg8::Gemm g{WSP(bf16, WS_XN), WSP(bf16, WS_WIN), T, INC, D}; pg8::StaticOrder S; S.init(T, INC, G, bid);
            pg8::EpiBf16<0> E{WSP(bf16, WS_Z), D, nullptr, D, (size_t)(ZSTRIDE / 2), 1.f, l == 0 ? (const ss_t*)WSP(ss_t, WS_SS0) : (const ss_t*)WSP(ss_t, WS_SSC)};
            pg8::gemm_phase<pg8::EpiBf16<0>, pg8::StaticOrder, PG8_ALIGN, PG8_SP2>(ring, g, S, E);
        }
        GRID_BAR();
        if (MK_PHASE_MASK & 1u) {
            for (int rep = 0; rep < REP_A; ++rep) if (CODE(3)) for (int u = bid; u < 512; u += G) r1_unit(F, u >> 2, u & 3);
            for (int rep = 0; rep < REP_LA; ++rep) if (CODE(4)) for (int u = bid; u < 256; u += G) lru_strip_agg(F, l, u >> 3, u & 7);
        }
        GRID_BAR();
        if (MK_PHASE_MASK & 1u) { if (CODE(5)) r2_scan(F); if (CODE(6)) lru_carry(F); }
        if (CODE(2)) for (int u = bid; u < 256; u += G) memkv_block(F, u);
        GRID_BAR();
        if (MK_PHASE_MASK & 1u) {
            for (int rep = 1; rep < REP_R3; ++rep) if (CODE(7)) for (int u = bid; u < 512; u += G) r3_unit<true>(F, u >> 2, u & 3);
            if (CODE(7)) for (int u = bid; u < 512; u += G) r3_unit<false>(F, u >> 2, u & 3);
            for (int rep = 0; rep < REP_LF; ++rep) if (CODE(8)) for (int u = bid; u < 256; u += G) lru_final(F, u >> 3, u & 7);
        }
        if (MK_PHASE_MASK & 2u) {
            for (int u = bid; u < 128; u += G) { if (u < 64) mx_fold_unit(F, l, u >> 4, (u >> 3) & 1, u & 7); else vo_fold_unit(F, (u - 64) >> 4, (u - 64) & 7, ((u - 64) >> 3) & 1); }
        }
        GRID_BAR();
        for (int rep = 0; rep < REP_M12; ++rep) if ((MK_PHASE_MASK & 1u) && CODE(9)) {
            {
                PH_BEGIN; pg8::Gemm g{WSP(bf16, WS_Z + 2 * ZSTRIDE), WSP(bf16, WS_WRET), T, D, D}; pg8::StaticOrder S; S.init(T, D, G, bid);
                pg8::EpiGateF32 E{WSP(bf16, WS_TMP), WSP(bf16, WS_Z + 5 * ZSTRIDE), D};
                pg8::gemm_phase<pg8::EpiGateF32, pg8::StaticOrder, PG8_ALIGN, PG8_SP2>(ring, g, S, E);
            }
            {
                PH_BEGIN; pg8::Gemm g{WSP(bf16, WS_Z + 4 * ZSTRIDE), WSP(bf16, WS_WRNN), T, D, D}; pg8::StaticOrder S; S.init(T, D, G, bid);
                pg8::EpiMergeBf16 E{WSP(bf16, WS_TMP), WSP(bf16, WS_Z + 6 * ZSTRIDE), WSP(bf16, WS_MERGED), D};
                pg8::gemm_phase<pg8::EpiMergeBf16, pg8::StaticOrder, PG8_ALIGN, PG8_SP2>(ring, g, S, E);
            }
        }
        RES_BAR();
        if ((MK_PHASE_MASK & 1u) && CODE(10)) {
            PH_BEGIN; pg8::Gemm g{WSP(bf16, WS_MERGED), WSP(bf16, WS_WMIX), T, D, D}; pg8::StaticOrder S; S.init(T, D, G, bid);
            pg8::EpiResid16 E{(const float*)nullptr, WSP(bf16, WS_XN), WSP(ss_t, WS_SSA), D};
            pg8::gemm_phase<pg8::EpiResid16, pg8::StaticOrder, PG8_ALIGN, PG8_SP2>(ring, g, S, E);
        }
        RES_BAR();
        if (MK_PHASE_MASK & 2u) {
            for (int rep = 0; rep < REP_XQ; ++rep) if (CODE(11)) {
                PH_BEGIN; pg8::Gemm g{WSP(bf16, WS_XN), WSP(bf16, WS_WXQ), T, D, D}; pg8::StaticOrder S; S.init(T, D, G, bid);
                EpiSoftmax E{WSP(ss_t, WS_SSA), WSP(bf16, WS_QX)};
                pg8::gemm_phase<EpiSoftmax, pg8::StaticOrder, false, PG8_SP2>(ring, g, S, E);
            }
            RES_BAR();
            if (CODE(13)) {
                PH_BEGIN; pg8::Gemm g{WSP(bf16, WS_QX), WSP(bf16, WS_WXV), T, D, D}; pg8::StaticOrder S; S.init(T, D, G, bid);
                pg8::EpiResid16 E{nullptr, WSP(bf16, WS_XN), WSP(ss_t, WS_SSB), D};
                pg8::gemm_phase<pg8::EpiResid16, pg8::StaticOrder, PG8_ALIGN, PG8_SP2>(ring, g, S, E);
            }
            RES_BAR();
        }
        if (MK_PHASE_MASK & 4u) {
            for (int rep = 0; rep < REP_PQ; ++rep) if (CODE(14)) {
#pragma unroll 1
                for (int half = 0; half < 2; ++half) {
                    PH_BEGIN; pg8::Gemm g{WSP(bf16, WS_XN), WSP(bf16, WS_WPQ) + (size_t)half * 1024 * 1024, T, D, D}; pg8::StaticOrder S; S.init(T, D, G, bid);
                    EpiTopk E{WSP(ss_t, WS_SSB), WSP(unsigned short, WS_IDX), WSP(float, WS_GATE), 4 * half};
                    pg8::gemm_phase<EpiTopk, pg8::StaticOrder, false, PG8_SP2>(ring, g, S, E);
                }
            }
            GRID_BAR();
#pragma unroll 1
            for (int rep = 0; rep < REP_GA; ++rep) if (CODE(16)) peer_u_phase<false>(F);
            GRID_BAR();
            if (CODE(16)) peer_combine(F);
            GRID_BAR();
#ifndef REP_V
#define REP_V 1
#endif
#pragma unroll 1
            for (int rep = 0; rep < REP_V; ++rep) if (CODE(16)) peer_v_phase(F, l, rep + 1 < REP_V);
            GRID_BAR();
            if (l + 1 == NLAYER) final_norm(F);
#ifdef EXTRA_BARS
            if (l + 1 < NLAYER) for (int e_ = 0; e_ < EXTRA_BARS; ++e_) GRID_BAR();
#endif
        }
    }
}

extern "C" void kernel_launch(void* const* d_in, const int* in_sizes, int n_in, void* d_out, int out_size, void* d_ws, size_t ws_size, hipStream_t stream) {
    static int grid = 0;
    if (grid == 0) {
        if (n_in != 28 || in_sizes[0] != T * D || out_size != T * D || ws_size < WS_END) { fprintf(stderr, "kernel_launch: built for 28 inputs, x and out of %d floats, >= %zu bytes of workspace; got n_in %d, in0 %d, out %d, ws %zu; nothing launched\n", T * D, (size_t)WS_END, n_in, n_in > 0 ? in_sizes[0] : -1, out_size, ws_size); grid = -1; return; }
        int dev = 0, cus = 0, per_cu = 0;
        if (hipGetDevice(&dev) != hipSuccess || hipDeviceGetAttribute(&cus, hipDeviceAttributeMultiprocessorCount, dev) != hipSuccess) { fprintf(stderr, "kernel_launch: hipGetDevice / hipDeviceGetAttribute failed; nothing launched\n"); grid = -1; return; }
        if (hipFuncSetAttribute((const void*)mk_fwd, hipFuncAttributeMaxDynamicSharedMemorySize, LDS_BYTES) != hipSuccess) { fprintf(stderr, "kernel_launch: hipFuncSetAttribute failed (%d bytes of dynamic LDS); nothing launched\n", LDS_BYTES); grid = -1; return; }
        if (hipOccupancyMaxActiveBlocksPerMultiprocessor(&per_cu, (const void*)mk_fwd, NWAVES * 64, LDS_BYTES) != hipSuccess || per_cu < 1)
            fprintf(stderr, "kernel_launch: note: the occupancy query reports %d workgroups per CU\n", per_cu);
        (void)hipGetLastError();
        grid = cus;
    }
    if (grid < 0) return;
    if (hipMemsetAsync((char*)d_ws + WS_CTL, 0, CTL_ZERO_BYTES, stream) != hipSuccess) { fprintf(stderr, "kernel_launch: hipMemsetAsync of the control words failed; nothing launched\n"); return; }
    Args a{};
    for (int i = 0; i < 28; ++i) a.in[i] = (const float*)d_in[i];
    a.out = (float*)d_out; a.ws = (unsigned char*)d_ws;
    hipLaunchKernelGGL(mk_fwd, dim3(grid), dim3(NWAVES * 64), LDS_BYTES, stream, a);
    const hipError_t le = hipPeekAtLastError();
    if (le != hipSuccess) fprintf(stderr, "kernel_launch: launch failed: %s (grid %d x %d threads, %d B LDS)\n", hipGetErrorName(le), grid, NWAVES * 64, LDS_BYTES);
}
```

```cpp
#include <hip/hip_runtime.h>
#include <cstdio>
#include <cstdint>
namespace pg8 {
#define PG8_LAS __attribute__((address_space(3)))
typedef unsigned short bf16_t;
typedef short bf16x8 __attribute__((ext_vector_type(8)));
typedef float f32x4 __attribute__((ext_vector_type(4)));
typedef unsigned u32x4 __attribute__((ext_vector_type(4)));
constexpr int BM = 256, BK = 64, HALF = 128, HTB = HALF * BK * 2  , STAGE_BYTES = 8 * HTB, NXCD = 8, WGM = 8;

__host__ __device__ __forceinline__ int lds_byte(int r, int c) { const int st = (r >> 4) * 2 + (c >> 5), rr = r & 15, cc = c & 31, ob = rr * 64 + cc * 2; return st * 1024 + (ob ^ (((ob >> 9) & 1) << 5)); }
__host__ __device__ __forceinline__ void stage_rc(int b, int& R, int& C) { const int st = b / 1024, sb = b % 1024, swz = sb ^ (((sb >> 9) & 1) << 5); R = (st >> 1) * 16 + swz / 64; C = (st & 1) * 32 + (swz % 64) / 2; }
__host__ __device__ __forceinline__ int perm32(int rho) { const int n = rho >> 4, i = rho & 15; return 8 * (i >> 2) + 4 * n + (i & 3); }

struct Unit { int pm, pn; };
struct Gemm { const bf16_t* A; const bf16_t* Bt; int M, N, K; };

struct StaticOrder {
    int nM, nN, nwg, G, c;
    __host__ __device__ void init(int M, int N, int G_, int c_) { nM = M / BM; nN = N / BM; nwg = nM * nN; G = G_; c = c_; }
    __host__ __device__ bool next(int i, Unit& u) const {
        const long L = (long)i * G + c; if (L >= nwg) return false;
        int wgid = (int)L; { const int q = nwg / NXCD, r = nwg % NXCD, xcd = wgid % NXCD, off = wgid / NXCD; wgid = (xcd < r ? xcd * (q + 1) : r * (q + 1) + (xcd - r) * q) + off; }
        const int nig = WGM * nN, gid = wgid / nig, fm = gid * WGM, gsz = (nM - fm) < WGM ? (nM - fm) : WGM;
        u.pm = fm + ((wgid % nig) % gsz); u.pn = (wgid % nig) / gsz; return true;
    }
    __device__ __forceinline__ void a_ready(const Unit&) const {}
    __device__ __forceinline__ void done(const Unit&) const {}
};

typedef float pg8_f2_t __attribute__((ext_vector_type(2)));
typedef __bf16 pg8_b2_t __attribute__((ext_vector_type(2)));
__device__ __forceinline__ unsigned cvt_pk_bf16(float lo, float hi) { const pg8_f2_t v = {lo, hi}; const pg8_b2_t r = __builtin_convertvector(v, pg8_b2_t); return __builtin_bit_cast(unsigned, r); }
typedef float f32x2 __attribute__((ext_vector_type(2)));
__device__ __forceinline__ f32x2 gelu_pk(f32x2 v) {
    const f32x2 av = __builtin_elementwise_abs(v), d = av * 0.2316418882f + 1.0f;
    f32x2 t; t.x = __builtin_amdgcn_rcpf(d.x); t.y = __builtin_amdgcn_rcpf(d.y);
    f32x2 q = t * 0.5307027145f + (-0.7265760135f); q = q * t + 0.7107068705f; q = q * t + (-0.142248368f); q = q * t + 0.127414796f; q = q * t;
    const f32x2 s = (v * v) * (-0.72134752044f);
    f32x2 e; e.x = __builtin_amdgcn_exp2f(s.x); e.y = __builtin_amdgcn_exp2f(s.y);
    const f32x2 m = v * (q * e), r = v - m;
    f32x2 o; o.x = v.x < 0.f ? m.x : r.x; o.y = v.y < 0.f ? m.y : r.y; return o;
}

template <int ACT  > struct EpiBf16 {
    static constexpr bool PERM = true, AFTER_DRAIN = false; static_assert(ACT == 0 || ACT == 1, "EpiBf16: ACT is 0 (none) or 1 (gelu_pk)");
    bf16_t* O; int ldc; const float* bias; int split_cols; size_t split_stride; float scale0; const unsigned long long* rowss;
    __device__ __forceinline__ void operator()(const f32x4 (&acc)[2][2][4][2], const Unit& u, int wr, int wc, int fr, int fq) const {
        const int row0 = u.pm * BM + wr * 64 + fr; int colt = u.pn * BM; bf16_t* base = O;
        float sc = 1.f; if (split_cols) { const int t = colt / split_cols; base += (size_t)t * split_stride; colt -= t * split_cols; if (t == 0) sc = scale0; }
        const int col0 = colt + wc * 32 + 8 * fq, bcol0 = u.pn * BM + wc * 32 + 8 * fq;
        f32x4 bv[2][2];
#pragma unroll
        for (int bj = 0; bj < 2; ++bj)
#pragma unroll
            for (int n = 0; n < 2; ++n) bv[bj][n] = bias ? *(const f32x4*)(bias + bcol0 + bj * HALF + 4 * n) : (f32x4){0.f, 0.f, 0.f, 0.f};
        unsigned long long rsv[2][4];
#pragma unroll
        for (int ai = 0; ai < 2; ++ai)
#pragma unroll
            for (int m = 0; m < 4; ++m) rsv[ai][m] = rowss ? rowss[row0 + ai * HALF + m * 16] : 0ull;
        asm volatile("" : "+v"(rsv[0][0]), "+v"(rsv[0][1]), "+v"(rsv[0][2]), "+v"(rsv[0][3]), "+v"(rsv[1][0]), "+v"(rsv[1][1]), "+v"(rsv[1][2]), "+v"(rsv[1][3]) :: "memory");
#pragma unroll
        for (int ai = 0; ai < 2; ++ai)
#pragma unroll
            for (int m = 0; m < 4; ++m) { bf16_t* rowp = base + (size_t)(row0 + ai * HALF + m * 16) * ldc + col0;
                const float rsc = rowss ? sc * __builtin_amdgcn_rsqf((float)rsv[ai][m] * (1.0f / 4294967296.0f / 1024.0f) + 1e-6f) : sc;
#pragma unroll
                for (int bj = 0; bj < 2; ++bj) { f32x4 v0 = acc[ai][bj][m][0] + bv[bj][0], v1 = acc[ai][bj][m][1] + bv[bj][1];
                    if (ACT == 1) { f32x2 a = gelu_pk((f32x2){v0[0], v0[1]}), b = gelu_pk((f32x2){v0[2], v0[3]}), c = gelu_pk((f32x2){v1[0], v1[1]}), d = gelu_pk((f32x2){v1[2], v1[3]});
                        v0 = (f32x4){a.x, a.y, b.x, b.y}; v1 = (f32x4){c.x, c.y, d.x, d.y}; }
                    v0 = v0 * rsc; v1 = v1 * rsc; u32x4 w; w.x = cvt_pk_bf16(v0[0], v0[1]); w.y = cvt_pk_bf16(v0[2], v0[3]); w.z = cvt_pk_bf16(v1[0], v1[1]); w.w = cvt_pk_bf16(v1[2], v1[3]);
                    *(u32x4*)(rowp + bj * HALF) = w; } }
    }
};
template <class Epi, class Sched, bool ALIGN_EPI = false, bool SP2 = false>
__device__ __forceinline__ void gemm_phase(PG8_LAS unsigned char* lds, const Gemm g, const Sched& S, const Epi& E) {
    int tid_l = threadIdx.x; asm volatile("" : "+v"(tid_l));
    const int tid = tid_l, wid = __builtin_amdgcn_readfirstlane(tid >> 6), lane = tid & 63, wr = wid >> 2, wc = wid & 3, fr = lane & 15, fq = lane >> 4;
    const int K = g.K, nt = K / BK;
    unsigned voffA[2], voffB[2];
#pragma unroll
    for (int i = 0; i < 2; ++i) { int R, C; stage_rc(tid * 16 + i * 8192, R, C); const int Rb = Epi::PERM ? ((R & ~31) + perm32(R & 31)) : R;
        voffA[i] = (unsigned)(R * K + C) * 2u; voffB[i] = (unsigned)(Rb * K + C) * 2u; }
    const size_t kstep = (size_t)(BK * 2);
    const size_t hstep = (size_t)HALF * K * 2;
    const size_t tstep = 2 * hstep;
    const unsigned ldsw = (unsigned)wid * 1024u;
    const int aoff = lds_byte(wr * 64 + fr, fq * 8), boff = lds_byte(wc * 32 + fr, fq * 8);
#define PG8_SA(b, h) (((b) * 2 + (h)) * HTB)
#define PG8_SB(b, h) ((4 + (b) * 2 + (h)) * HTB)
#define PG8_STAGE(bufoff, gbase, voff) do { _Pragma("unroll") for (int _i = 0; _i < 2; ++_i) \
        __builtin_amdgcn_global_load_lds((const unsigned*)((const char*)(gbase) + (voff)[_i]), (PG8_LAS unsigned*)(lds + (bufoff) + ldsw + _i * 8192), 16, 0, 0); } while (0)
#define PG8_LDA(dst, b, h) do { _Pragma("unroll") for (int m = 0; m < 4; ++m) _Pragma("unroll") for (int k = 0; k < 2; ++k) dst[m][k] = *(const PG8_LAS bf16x8*)(lds + PG8_SA(b, h) + aoff + m * 2048 + k * 1024); } while (0)
#define PG8_LDB(dst, b, h) do { _Pragma("unroll") for (int n = 0; n < 2; ++n) _Pragma("unroll") for (int k = 0; k < 2; ++k) dst[n][k] = *(const PG8_LAS bf16x8*)(lds + PG8_SB(b, h) + boff + n * 2048 + k * 1024); } while (0)
#define PG8_MMA(ai, bj, At, Bt) do { __builtin_amdgcn_s_setprio(1); _Pragma("unroll") for (int m = 0; m < 4; ++m) _Pragma("unroll") for (int n = 0; n < 2; ++n) _Pragma("unroll") for (int k = 0; k < 2; ++k) \
        acc[ai][bj][m][n] = __builtin_amdgcn_mfma_f32_16x16x32_bf16(Bt[n][k], At[m][k], acc[ai][bj][m][n], 0, 0, 0); __builtin_amdgcn_s_setprio(0); } while (0)
#define PG8_WAIT_V(n) asm volatile("s_waitcnt vmcnt(" #n ")" ::: "memory")
#define PG8_WAIT_L(n) asm volatile("s_waitcnt lgkmcnt(" #n ")" ::: "memory")
#define PG8_BAR __builtin_amdgcn_s_barrier()
#define PG8_SCHED __builtin_amdgcn_sched_barrier(0)
    Unit cur, nxt; int ui = 0;
    if (!S.next(0, cur)) return;
    f32x4 acc[2][2][4][2];
#pragma unroll
    for (int a = 0; a < 2; ++a)
#pragma unroll
        for (int b = 0; b < 2; ++b)
#pragma unroll
            for (int m = 0; m < 4; ++m)
#pragma unroll
                for (int n = 0; n < 2; ++n) acc[a][b][m][n] = (f32x4){0.f, 0.f, 0.f, 0.f};
    bf16x8 At[4][2], B0[2][2], B1[2][2];
    const char* cA = (const char*)g.A + (size_t)cur.pm * tstep; const char* cB = (const char*)g.Bt + (size_t)cur.pn * tstep;
    S.a_ready(cur);
    if constexpr (SP2) {
        PG8_STAGE(PG8_SB(0, 0), cB, voffB); PG8_STAGE(PG8_SB(0, 1), cB + hstep, voffB); PG8_STAGE(PG8_SA(0, 0), cA, voffA); PG8_STAGE(PG8_SA(0, 1), cA + hstep, voffA);
        if (wr == 1) PG8_BAR;
        PG8_WAIT_V(2); PG8_BAR;
        PG8_STAGE(PG8_SB(1, 0), cB + kstep, voffB); PG8_STAGE(PG8_SA(1, 0), cA + kstep, voffA); PG8_STAGE(PG8_SB(1, 1), cB + hstep + kstep, voffB);
        PG8_WAIT_V(6); PG8_BAR;
    } else {
        PG8_STAGE(PG8_SB(0, 0), cB, voffB); PG8_STAGE(PG8_SA(0, 0), cA, voffA); PG8_STAGE(PG8_SB(0, 1), cB + hstep, voffB); PG8_STAGE(PG8_SA(0, 1), cA + hstep, voffA);
        if (wr == 1) PG8_BAR;
        PG8_WAIT_V(4); PG8_BAR;
        PG8_STAGE(PG8_SB(1, 0), cB + kstep, voffB); PG8_STAGE(PG8_SA(1, 0), cA + kstep, voffA); PG8_STAGE(PG8_SB(1, 1), cB + hstep + kstep, voffB);
        PG8_WAIT_V(6); PG8_BAR;
    }
    for (;;) {
        const bool has_next = S.next(ui + 1, nxt);
        const char* nA = has_next ? (const char*)g.A + (size_t)nxt.pm * tstep : cA; const char* nB = has_next ? (const char*)g.Bt + (size_t)nxt.pn * tstep : cB;
        for (int t = 0; t < nt; t += 2) {
            const bool last = (t == nt - 2);
            const char* a1 = cA + (size_t)(t + 1) * kstep;
            const char* a2 = last ? nA : cA + (size_t)(t + 2) * kstep; const char* b2 = last ? nB : cB + (size_t)(t + 2) * kstep;
            const char* a3 = a2 + kstep; const char* b3 = b2 + kstep;
            if (last && has_next) S.a_ready(nxt);
            if constexpr (SP2) {
            PG8_LDB(B0, 0, 0); PG8_LDB(B1, 0, 1); PG8_SCHED; PG8_LDA(At, 0, 0); PG8_STAGE(PG8_SA(1, 1), a1 + hstep, voffA);
            PG8_WAIT_V(8); PG8_WAIT_L(0); PG8_BAR; PG8_MMA(0, 0, At, B0); PG8_MMA(0, 1, At, B1); PG8_BAR; PG8_SCHED;
            PG8_LDA(At, 0, 1); PG8_STAGE(PG8_SB(0, 0), b2, voffB); PG8_STAGE(PG8_SB(0, 1), b2 + hstep, voffB); PG8_STAGE(PG8_SA(0, 0), a2, voffA);
            PG8_WAIT_V(8); PG8_WAIT_L(0); PG8_BAR; PG8_MMA(1, 0, At, B0); PG8_MMA(1, 1, At, B1); PG8_BAR; PG8_SCHED;
            PG8_LDB(B0, 1, 0); PG8_LDB(B1, 1, 1); PG8_SCHED; PG8_LDA(At, 1, 0); PG8_STAGE(PG8_SA(0, 1), a2 + hstep, voffA);
            PG8_WAIT_V(8); PG8_WAIT_L(0); PG8_BAR; PG8_MMA(0, 0, At, B0); PG8_MMA(0, 1, At, B1); PG8_BAR; PG8_SCHED;
            PG8_LDA(At, 1, 1); PG8_STAGE(PG8_SB(1, 0), b3, voffB); PG8_STAGE(PG8_SB(1, 1), b3 + hstep, voffB); PG8_STAGE(PG8_SA(1, 0), a3, voffA);
            PG8_WAIT_V(8); PG8_WAIT_L(0); PG8_BAR; PG8_MMA(1, 0, At, B0); PG8_MMA(1, 1, At, B1); PG8_BAR; PG8_SCHED;
            } else {
            PG8_LDB(B0, 0, 0); PG8_SCHED; PG8_LDA(At, 0, 0); PG8_STAGE(PG8_SA(1, 1), a1 + hstep, voffA);
            PG8_WAIT_L(8); PG8_BAR; PG8_WAIT_L(0); PG8_MMA(0, 0, At, B0); PG8_BAR; PG8_SCHED;
            PG8_LDB(B1, 0, 1); PG8_STAGE(PG8_SB(0, 0), b2, voffB);
            PG8_BAR; PG8_WAIT_L(0); PG8_MMA(0, 1, At, B1); PG8_BAR;
            PG8_LDA(At, 0, 1); PG8_STAGE(PG8_SA(0, 0), a2, voffA);
            PG8_BAR; PG8_WAIT_L(0); PG8_MMA(1, 0, At, B0); PG8_BAR; PG8_SCHED;
            PG8_STAGE(PG8_SB(0, 1), b2 + hstep, voffB);
            PG8_WAIT_V(6); PG8_BAR; PG8_MMA(1, 1, At, B1); PG8_BAR;
            PG8_LDB(B0, 1, 0); PG8_SCHED; PG8_LDA(At, 1, 0); PG8_STAGE(PG8_SA(0, 1), a2 + hstep, voffA);
            PG8_WAIT_L(8); PG8_BAR; PG8_WAIT_L(0); PG8_MMA(0, 0, At, B0); PG8_BAR; PG8_SCHED;
            PG8_LDB(B1, 1, 1); PG8_STAGE(PG8_SB(1, 0), b3, voffB);
            PG8_BAR; PG8_WAIT_L(0); PG8_MMA(0, 1, At, B1); PG8_BAR;
            PG8_LDA(At, 1, 1); PG8_STAGE(PG8_SA(1, 0), a3, voffA);
            PG8_BAR; PG8_WAIT_L(0); PG8_MMA(1, 0, At, B0); PG8_BAR; PG8_SCHED;
            PG8_STAGE(PG8_SB(1, 1), b3 + hstep, voffB);
            PG8_WAIT_V(6); PG8_BAR; PG8_MMA(1, 1, At, B1); PG8_BAR;
            }
        }
        if constexpr (ALIGN_EPI) { if (wr == 0) PG8_BAR; }
        if constexpr (!Epi::AFTER_DRAIN) { E(acc, cur, wr, wc, fr, fq); S.done(cur); }
        if (!has_next) break;
#pragma unroll
        for (int a = 0; a < 2; ++a)
#pragma unroll
            for (int b = 0; b < 2; ++b)
#pragma unroll
                for (int m = 0; m < 4; ++m)
#pragma unroll
                    for (int n = 0; n < 2; ++n) acc[a][b][m][n] = (f32x4){0.f, 0.f, 0.f, 0.f};
        cur = nxt; cA = nA; cB = nB; ++ui;
        if constexpr (ALIGN_EPI) { if (wr == 1) PG8_BAR; }
    }
    PG8_WAIT_V(0);
    if constexpr (!ALIGN_EPI) { if (wr == 0) PG8_BAR; }
    PG8_BAR;
    if constexpr (Epi::AFTER_DRAIN) { E.fused(acc, cur, wr, wc, fr, fq, lds, wid, lane); S.done(cur); }
#undef PG8_SA
#undef PG8_SB
#undef PG8_STAGE
#undef PG8_LDA
#undef PG8_LDB
#undef PG8_MMA
#undef PG8_WAIT_V
#undef PG8_WAIT_L
#undef PG8_BAR
#undef PG8_SCHED
}
}

#ifndef PG8_SP2
#define PG8_SP2 true
#endif
#ifndef PG8_ALIGN
#define PG8_ALIGN true
#endif
namespace pg8 {
typedef unsigned u32x2 __attribute__((ext_vector_type(2)));
__device__ __forceinline__ float bflo(unsigned u) { return __builtin_bit_cast(float, u << 16); }
__device__ __forceinline__ float bfhi(unsigned u) { return __builtin_bit_cast(float, u & 0xffff0000u); }
__device__ __forceinline__ float sigm(float x) { return __builtin_amdgcn_rcpf(1.0f + __expf(-x)); }
struct EpiGateF32 {
    static constexpr bool PERM = true, AFTER_DRAIN = false;
    bf16_t* O; const bf16_t* G; int ld;
    __device__ __forceinline__ void operator()(const f32x4 (&acc)[2][2][4][2], const Unit& u, int wr, int wc, int fr, int fq) const {
        const int row0 = u.pm * BM + wr * 64 + fr, col0 = u.pn * BM + wc * 32 + 8 * fq;
#pragma unroll
        for (int ai = 0; ai < 2; ++ai) {
            u32x4 gl[4][2];
#pragma unroll
            for (int m = 0; m < 4; ++m)
#pragma unroll
                for (int bj = 0; bj < 2; ++bj) gl[m][bj] = *(const u32x4*)(G + (size_t)(row0 + ai * HALF + m * 16) * ld + col0 + bj * HALF);
#pragma unroll
            for (int m = 0; m < 4; ++m)
#pragma unroll
                for (int bj = 0; bj < 2; ++bj) { const u32x4 gv = gl[m][bj];
                    f32x4 s0, s1; s0[0] = sigm(bflo(gv.x)); s0[1] = sigm(bfhi(gv.x)); s0[2] = sigm(bflo(gv.y)); s0[3] = sigm(bfhi(gv.y)); s1[0] = sigm(bflo(gv.z)); s1[1] = sigm(bfhi(gv.z)); s1[2] = sigm(bflo(gv.w)); s1[3] = sigm(bfhi(gv.w));
                    const f32x4 r0 = acc[ai][bj][m][0] * s0, r1 = acc[ai][bj][m][1] * s1;
                    u32x4 w; w.x = cvt_pk_bf16(r0[0], r0[1]); w.y = cvt_pk_bf16(r0[2], r0[3]); w.z = cvt_pk_bf16(r1[0], r1[1]); w.w = cvt_pk_bf16(r1[2], r1[3]);
                    *(u32x4*)(O + (size_t)(row0 + ai * HALF + m * 16) * ld + col0 + bj * HALF) = w; }
        }
    }
};
struct EpiMergeBf16 {
    static constexpr bool PERM = true, AFTER_DRAIN = false;
    const bf16_t* Tm; const bf16_t* G; bf16_t* O; int ld;
    __device__ __forceinline__ void operator()(const f32x4 (&acc)[2][2][4][2], const Unit& u, int wr, int wc, int fr, int fq) const {
        const int row0 = u.pm * BM + wr * 64 + fr, col0 = u.pn * BM + wc * 32 + 8 * fq;
#pragma unroll
        for (int ai = 0; ai < 2; ++ai) {
            u32x4 gl[4][2], tl[4][2];
#pragma unroll
            for (int m = 0; m < 4; ++m)
#pragma unroll
                for (int bj = 0; bj < 2; ++bj) { const size_t o = (size_t)(row0 + ai * HALF + m * 16) * ld + col0 + bj * HALF; gl[m][bj] = *(const u32x4*)(G + o); tl[m][bj] = *(const u32x4*)(Tm + o); }
#pragma unroll
            for (int m = 0; m < 4; ++m)
#pragma unroll
                for (int bj = 0; bj < 2; ++bj) { const u32x4 gv = gl[m][bj], tq = tl[m][bj];
                    f32x4 s0, s1; s0[0] = sigm(bflo(gv.x)); s0[1] = sigm(bfhi(gv.x)); s0[2] = sigm(bflo(gv.y)); s0[3] = sigm(bfhi(gv.y)); s1[0] = sigm(bflo(gv.z)); s1[1] = sigm(bfhi(gv.z)); s1[2] = sigm(bflo(gv.w)); s1[3] = sigm(bfhi(gv.w));
                    const f32x4 t0 = {bflo(tq.x), bfhi(tq.x), bflo(tq.y), bfhi(tq.y)}, t1 = {bflo(tq.z), bfhi(tq.z), bflo(tq.w), bfhi(tq.w)};
                    const f32x4 r0 = t0 + acc[ai][bj][m][0] * s0, r1 = t1 + acc[ai][bj][m][1] * s1;
                    u32x4 w; w.x = cvt_pk_bf16(r0[0], r0[1]); w.y = cvt_pk_bf16(r0[2], r0[3]); w.z = cvt_pk_bf16(r1[0], r1[1]); w.w = cvt_pk_bf16(r1[2], r1[3]);
                    *(u32x4*)(O + (size_t)(row0 + ai * HALF + m * 16) * ld + col0 + bj * HALF) = w; }
        }
    }
};
struct EpiResid16 {
    static constexpr bool PERM = true, AFTER_DRAIN = false;
    const float* Xin32; bf16_t* X16; unsigned long long* SS; int ld;
    __device__ __forceinline__ void operator()(const f32x4 (&acc)[2][2][4][2], const Unit& u, int wr, int wc, int fr, int fq) const {
        const int row0 = u.pm * BM + wr * 64 + fr, col0 = u.pn * BM + wc * 32 + 8 * fq;
#pragma unroll
        for (int ai = 0; ai < 2; ++ai) {
            u32x4 xb[4][2];
#pragma unroll
            for (int m = 0; m < 4; ++m)
#pragma unroll
                for (int bj = 0; bj < 2; ++bj) xb[m][bj] = *(const u32x4*)(X16 + (size_t)(row0 + ai * HALF + m * 16) * ld + col0 + bj * HALF);
#pragma unroll
            for (int m = 0; m < 4; ++m) { const int row = row0 + ai * HALF + m * 16; float ss = 0.f;
#pragma unroll
                for (int bj = 0; bj < 2; ++bj) { const u32x4 q = xb[m][bj];
                    const f32x4 x0 = (f32x4){bflo(q.x), bfhi(q.x), bflo(q.y), bfhi(q.y)} + acc[ai][bj][m][0], x1 = (f32x4){bflo(q.z), bfhi(q.z), bflo(q.w), bfhi(q.w)} + acc[ai][bj][m][1];
                    u32x4 w; w.x = cvt_pk_bf16(x0[0], x0[1]); w.y = cvt_pk_bf16(x0[2], x0[3]); w.z = cvt_pk_bf16(x1[0], x1[1]); w.w = cvt_pk_bf16(x1[2], x1[3]);
                    *(u32x4*)(X16 + (size_t)row * ld + col0 + bj * HALF) = w;
                    const float r0 = bflo(w.x), r1 = bfhi(w.x), r2 = bflo(w.y), r3 = bfhi(w.y), r4 = bflo(w.z), r5 = bfhi(w.z), r6 = bflo(w.w), r7 = bfhi(w.w);
                    ss += ((r0 * r0 + r1 * r1) + (r2 * r2 + r3 * r3)) + ((r4 * r4 + r5 * r5) + (r6 * r6 + r7 * r7)); }
                { const auto s16 = __builtin_amdgcn_permlane16_swap(__builtin_bit_cast(unsigned, ss), __builtin_bit_cast(unsigned, ss), false, false); const unsigned p0 = s16[0], p1 = s16[1]; ss = __builtin_bit_cast(float, p0) + __builtin_bit_cast(float, p1);
                  const auto s32 = __builtin_amdgcn_permlane32_swap(__builtin_bit_cast(unsigned, ss), __builtin_bit_cast(unsigned, ss), false, false); const unsigned q0 = s32[0], q1 = s32[1]; ss = __builtin_bit_cast(float, q0) + __builtin_bit_cast(float, q1); }
                if (fq == 0) atomicAdd(SS + row, (unsigned long long)(ss * 4294967296.0f)); }
        }
    }
};
}

constexpr int NWAVES = 8, NTHR = 512;
constexpr int T = 16384, D = 1024, NLAYER = 2, INC = 7168, PQC = 2048;
constexpr float EPS = 1e-6f;
constexpr size_t MiB = 1u << 20;
constexpr size_t WS_CTL = 0, CTL_ZERO_BYTES = 1 * MiB;
constexpr size_t WS_WIN = 2 * MiB, WS_WRET = 16 * MiB, WS_WRNN = 18 * MiB, WS_WMIX = 20 * MiB, WS_WXQ = 22 * MiB, WS_WXK = 24 * MiB, WS_WXV = 26 * MiB, WS_WXO = 28 * MiB, WS_WPQ = 30 * MiB;
constexpr size_t WS_LWA = 34 * MiB, WS_LWX = 34 * MiB + 256 * 1024, WS_SK1 = 34 * MiB + 512 * 1024, WS_SK2 = 34 * MiB + 768 * 1024;
constexpr size_t WS_MEMN = 35 * MiB, WS_KMEM = 35 * MiB + 512 * 1024, WS_VMEMT = 36 * MiB;
constexpr size_t WS_COS = 37 * MiB;
constexpr size_t WS_AGGA = 45 * MiB, WS_AGGB = 46 * MiB, WS_HIN = 47 * MiB;
typedef unsigned long long ss_t;
constexpr size_t WS_SS0 = 46 * MiB + 256 * 1024, WS_SSA = 46 * MiB + 384 * 1024, WS_SSB = 46 * MiB + 512 * 1024, WS_SSC = 46 * MiB + 640 * 1024;
constexpr size_t WS_SSA_DOC = 0;
constexpr size_t WS_PU8 = 48 * MiB, WS_PV8 = 64 * MiB, WS_SCU = 45 * MiB + 768 * 1024, WS_SCV = 45 * MiB + 832 * 1024;
constexpr size_t WS_LB = 80 * MiB;
constexpr size_t WS_XN = 112 * MiB;
constexpr size_t WS_PV8B = 448 * MiB;
constexpr size_t WS_LA = 400 * MiB;
constexpr size_t WS_Z = 144 * MiB, ZSTRIDE = 32 * MiB;
constexpr size_t WS_KV = 368 * MiB, WS_END = 464 * MiB;
constexpr size_t WS_TMP = WS_Z;
constexpr size_t WS_MERGED = WS_Z + 3 * ZSTRIDE;
constexpr size_t WS_QX = WS_Z + 3 * ZSTRIDE;
constexpr size_t WS_PQ = WS_Z + 2 * ZSTRIDE;
constexpr size_t WS_IDX = WS_KV, WS_GATE = WS_KV + 8 * MiB;
constexpr size_t WS_SRAW = WS_Z + 5 * ZSTRIDE;
constexpr size_t WS_PW = WS_Z;
constexpr size_t SLICE_BYTES = (size_t)16384 * 128;
constexpr int CW_BAR = 4096;
constexpr int LDS_BYTES = 163840;
constexpr int LDSCTL_OFF = 163840 - 512, MISC_OFF = LDSCTL_OFF;

#define GAS __attribute__((address_space(1)))
#define LAS __attribute__((address_space(3)))
typedef unsigned short bf16;
#define KEEP2(a, b) asm volatile("" : "+v"(a), "+v"(b) :: "memory")
#define KEEP4(a, b, c, d) asm volatile("" : "+v"(a), "+v"(b), "+v"(c), "+v"(d) :: "memory")
#define KEEP6(a, b, c, d, e, f) asm volatile("" : "+v"(a), "+v"(b), "+v"(c), "+v"(d), "+v"(e), "+v"(f) :: "memory")
#define KEEP8(x) asm volatile("" : "+v"((x)[0]), "+v"((x)[1]), "+v"((x)[2]), "+v"((x)[3]), "+v"((x)[4]), "+v"((x)[5]), "+v"((x)[6]), "+v"((x)[7]) :: "memory")
typedef unsigned v4u __attribute__((ext_vector_type(4)));
typedef unsigned v2u __attribute__((ext_vector_type(2)));
typedef float f32x4 __attribute__((ext_vector_type(4)));
typedef short bf16x8 __attribute__((ext_vector_type(8)));
typedef short s16x4 __attribute__((ext_vector_type(4)));
typedef __bf16 bf16x2_t __attribute__((ext_vector_type(2)));
typedef GAS unsigned gu32;
#define RLX_AGENT __ATOMIC_RELAXED, __HIP_MEMORY_SCOPE_AGENT
#define LDS_WAIT() asm volatile("s_waitcnt lgkmcnt(0)" ::: "memory")
typedef float cvf2_t __attribute__((ext_vector_type(2)));
typedef __bf16 cvb2_t __attribute__((ext_vector_type(2)));
__device__ __forceinline__ unsigned cvt_pk_nv(float lo, float hi) { const cvf2_t v = {lo, hi}; const cvb2_t r = __builtin_convertvector(v, cvb2_t); return __builtin_bit_cast(unsigned, r); }
__device__ __forceinline__ unsigned f2bf(float f) { return cvt_pk_nv(f, f) & 0xffffu; }
__device__ __forceinline__ ss_t ss_fix(float s) { return (ss_t)(s * 4294967296.0f); }
__device__ __forceinline__ float ss_flt(ss_t v) { return (float)v * (1.0f / 4294967296.0f); }
__device__ __forceinline__ unsigned pk2(float lo, float hi) { return cvt_pk_nv(lo, hi); }
__device__ __forceinline__ float bf2f(bf16 b) { return __builtin_bit_cast(float, (unsigned)b << 16); }
__device__ __forceinline__ float bflo(unsigned u) { return __builtin_bit_cast(float, u << 16); }
__device__ __forceinline__ float bfhi(unsigned u) { return __builtin_bit_cast(float, u & 0xffff0000u); }
__device__ __forceinline__ float sigm(float x) { return __builtin_amdgcn_rcpf(1.0f + __expf(-x)); }
__device__ __forceinline__ float gelu_tanh(float x) { const float z = 0.7978845608028654f * (x + 0.044715f * x * x * x); const float th = 1.0f - 2.0f * __builtin_amdgcn_rcpf(1.0f + __expf(2.0f * z)); return 0.5f * x * (1.0f + th); }
template <int CTRL> __device__ __forceinline__ float dppf(float x) { return __builtin_bit_cast(float, __builtin_amdgcn_mov_dpp(__builtin_bit_cast(int, x), CTRL, 0xf, 0xf, true)); }
__device__ __forceinline__ float half_sum32(float a, float b) { const auto s = __builtin_amdgcn_permlane32_swap(__builtin_bit_cast(unsigned, a), __builtin_bit_cast(unsigned, b), false, false); const unsigned x0 = s[0], x1 = s[1]; return __builtin_bit_cast(float, x0) + __builtin_bit_cast(float, x1); }
__device__ __forceinline__ float half_sum16(float a, float b) { const auto s = __builtin_amdgcn_permlane16_swap(__builtin_bit_cast(unsigned, a), __builtin_bit_cast(unsigned, b), false, false); const unsigned x0 = s[0], x1 = s[1]; return __builtin_bit_cast(float, x0) + __builtin_bit_cast(float, x1); }
__device__ __forceinline__ float half_max32(float a) { const auto s = __builtin_amdgcn_permlane32_swap(__builtin_bit_cast(unsigned, a), __builtin_bit_cast(unsigned, a), false, false); const unsigned x0 = s[0], x1 = s[1]; return fmaxf(__builtin_bit_cast(float, x0), __builtin_bit_cast(float, x1)); }
__device__ __forceinline__ float half_max16(float a) { const auto s = __builtin_amdgcn_permlane16_swap(__builtin_bit_cast(unsigned, a), __builtin_bit_cast(unsigned, a), false, false); const unsigned x0 = s[0], x1 = s[1]; return fmaxf(__builtin_bit_cast(float, x0), __builtin_bit_cast(float, x1)); }
__device__ __forceinline__ float row_sum(float v) { v += dppf<0xB1>(v); v += dppf<0x4E>(v); v += dppf<0x141>(v); v += dppf<0x140>(v); return v; }
__device__ __forceinline__ float row_max(float v) { v = fmaxf(v, dppf<0xB1>(v)); v = fmaxf(v, dppf<0x4E>(v)); v = fmaxf(v, dppf<0x141>(v)); v = fmaxf(v, dppf<0x140>(v)); return v; }
__device__ __forceinline__ float cross_row_sum(float v) { v = half_sum16(v, v); return half_sum32(v, v); }
__device__ __forceinline__ float cross_row_max(float v) { v = half_max16(v); return half_max32(v); }
__device__ __forceinline__ float wave_sum(float v) { return cross_row_sum(row_sum(v)); }
__device__ __forceinline__ float wave_max(float v) { return cross_row_max(row_max(v)); }
#define MFMA16(a, b, c) __builtin_amdgcn_mfma_f32_16x16x32_bf16((a), (b), (c), 0, 0, 0)
__device__ __forceinline__ bf16x8 lds_rowfrag(LAS unsigned char* base, int stride, int row, int kcol) { return *(const LAS bf16x8*)(base + row * stride + kcol * 2); }
__device__ __forceinline__ bf16x8 lds_trfrag(LAS unsigned char* base, int stride, int krow0, int col0, int q, int p) {
    const s16x4 lo = __builtin_amdgcn_ds_read_tr16_b64_v4i16((LAS s16x4*)(base + (krow0 + q) * stride + (col0 + 4 * p) * 2));
    const s16x4 hi = __builtin_amdgcn_ds_read_tr16_b64_v4i16((LAS s16x4*)(base + (krow0 + 4 + q) * stride + (col0 + 4 * p) * 2));
    return __builtin_shufflevector(lo, hi, 0, 1, 2, 3, 4, 5, 6, 7);
}
#define XB_TMO      128
#define XB_XCNT(j)  (256  + 64 * (j))
#define XB_XSUB(j)  (1280 + 64 * (j))
#define XB_XGEN(j)  (2304 + 64 * (j))
#define XB_TOP      3328
#define XB_TOPGEN   3392
#define XCD_BAR_WORDS 3456
#define XB_LSUB(j)  (3520 + 64 * (j))
#define XB_XMASK(j) (4096 + 64 * (j))
#define XB_SPIN_CAP (1u << 18)

__device__ __forceinline__ unsigned xb_ld(unsigned* p)              { return __hip_atomic_load(p, __ATOMIC_RELAXED, __HIP_MEMORY_SCOPE_AGENT); }
__device__ __forceinline__ unsigned xb_add(unsigned* p, unsigned v) { return __hip_atomic_fetch_add(p, v, __ATOMIC_RELAXED, __HIP_MEMORY_SCOPE_AGENT); }
__device__ __forceinline__ unsigned xb_xcc_id() { return (unsigned)__builtin_amdgcn_s_getreg((3 << 11) | 20) & 0xFu; }
#define XB_SPIN(cond, bar) do { unsigned _sp = 0; while (cond) { __builtin_amdgcn_s_sleep(1); \
    if ((++_sp & 255u) == 0u) { if (xb_ld(&(bar)[XB_TMO])) break; if (_sp > XB_SPIN_CAP) { atomicAdd(&(bar)[XB_TMO], 1u); break; } } } } while (0)

struct XcdBarrier {
    unsigned* bar; unsigned x;
    volatile LAS unsigned* st;
};

__device__ __forceinline__ XcdBarrier xcd_barrier_post(unsigned* bar, volatile LAS unsigned* st) {
    XcdBarrier b; b.bar = bar; b.x = xb_xcc_id(); b.st = st;
    if (threadIdx.x == 0) (void)xb_add(&bar[XB_XCNT(b.x)], 1u);
    return b;
}
__device__ __forceinline__ void xcd_barrier_complete(unsigned* bar, unsigned x, unsigned& nloc, unsigned& nx) {
    const unsigned G = gridDim.x * gridDim.y * gridDim.z;
    unsigned sum, cnt, mine, sp = 0u;
    for (;;) {
        sum = 0u; cnt = 0u; mine = 0u;
#pragma unroll
        for (unsigned j = 0; j < 16; ++j) { const unsigned c = xb_ld(&bar[XB_XCNT(j)]); sum += c; cnt += (c > 0u) ? 1u : 0u; mine = (j == x) ? c : mine; }
        if (sum == G) break;
        __builtin_amdgcn_s_sleep(1);
        if ((++sp & 255u) == 0u) { if (xb_ld(&bar[XB_TMO])) break; if (sp > XB_SPIN_CAP) { atomicAdd(&bar[XB_TMO], 1u); break; } }
    }
    nloc = mine > 0u ? mine : 1u; nx = cnt > 0u ? cnt : 1u;
}

__device__ __forceinline__ void xcd_barrier(const XcdBarrier& b) {
    asm volatile("s_waitcnt vmcnt(0)" ::: "memory");
    __syncthreads();
    if (threadIdx.x == 0) {
        unsigned* bar = b.bar;
        __builtin_amdgcn_s_waitcnt(0);
        unsigned nloc = b.st[0], nx = b.st[1];
        if (nloc == 0u) { xcd_barrier_complete(bar, b.x, nloc, nx); b.st[0] = nloc; b.st[1] = nx; }
        const unsigned old = xb_add(&bar[XB_XSUB(b.x)], 1u);
        const unsigned gen = old / nloc;
        if (old + 1u == (gen + 1u) * nloc) {
            __builtin_amdgcn_fence(__ATOMIC_RELEASE, "agent");
            asm volatile("s_waitcnt vmcnt(0)" ::: "memory");
            const unsigned og = xb_add(&bar[XB_TOP], 1u);
            const unsigned tg = og / nx;
            if (og + 1u == (tg + 1u) * nx) xb_add(&bar[XB_TOPGEN], 1u);
            else XB_SPIN(xb_ld(&bar[XB_TOPGEN]) == tg, bar);
            __builtin_amdgcn_fence(__ATOMIC_ACQUIRE, "agent");
            xb_add(&bar[XB_XGEN(b.x)], 1u);
            asm volatile("s_waitcnt vmcnt(0)" ::: "memory");
        } else {
            XB_SPIN(xb_ld(&bar[XB_XGEN(b.x)]) == gen, bar);
            __builtin_amdgcn_fence(__ATOMIC_ACQUIRE, "agent");
            asm volatile("s_waitcnt vmcnt(0)" ::: "memory");
        }
    }
    __syncthreads();
}

__device__ __forceinline__ void res_barrier(const XcdBarrier& b, volatile LAS unsigned* local_ok, unsigned round) {
    if (*local_ok == 0u) { xcd_barrier(b); return; }
    asm volatile("s_waitcnt vmcnt(0)" ::: "memory");
    __syncthreads();
    if (threadIdx.x == 0) {
        unsigned* bar = b.bar;
        __builtin_amdgcn_s_waitcnt(0);
        const unsigned r = blockIdx.x & 7u, n = gridDim.x >> 3;
        (void)__hip_atomic_fetch_add(&bar[XB_LSUB(r)], 1u, __ATOMIC_RELAXED, __HIP_MEMORY_SCOPE_AGENT);
        const unsigned target = (round + 1u) * n;
        XB_SPIN(xb_ld(&bar[XB_LSUB(r)]) < target, bar);
        __builtin_amdgcn_fence(__ATOMIC_ACQUIRE, "agent");
        asm volatile("s_waitcnt vmcnt(0)" ::: "memory");
    }
    __syncthreads();
}

struct Args { const float* in[28]; float* out; unsigned char* ws; };
enum { I_X = 0, I_MEM, I_POS, I_GMIX, I_WIN, I_WRET, I_WRNN, I_WMIX, I_CONVW, I_CONVB, I_LWA, I_LBA, I_LWX, I_LBX, I_LAM, I_GX, I_GMEM, I_WXQ, I_WXK, I_WXV, I_WXO, I_GFFN, I_WPQ, I_SK1, I_SK2, I_PU, I_PV, I_GFIN };
struct Frame {
    LAS unsigned char* lds;
    int tid, lane, wave, vcu, G;
};
__device__ __forceinline__ Frame frame_local(const Frame& F0) { Frame F = F0; int t = F0.tid; asm volatile("" : "+v"(t)); F.tid = t; F.lane = t & 63; F.wave = __builtin_amdgcn_readfirstlane(t >> 6); return F; }
typedef const __attribute__((address_space(4))) unsigned long long* KArg;
__device__ __forceinline__ KArg ka_get() { KArg p = (KArg)__builtin_amdgcn_kernarg_segment_ptr(); asm volatile("" : "+s"(p)); return p; }
#define PH_BEGIN KArg const ka_ = ka_get(); GAS unsigned char* const ws_ = (GAS unsigned char*)ka_[29]; float* const X_ = (float*)(GAS float*)ka_[28]; (void)X_; (void)ws_
#define WSP(type, off) ((type*)(GAS type*)(ws_ + (off)))
#define INP(i) ((const float*)(GAS const float*)ka_[i])

template <bool HASG>
__device__ __forceinline__ void p0_transpose_item(const float* W, int K, int N, bf16* WT, int row_off, LAS float* scr, int item, int lane, const float* gk = nullptr) {
    const int nblk = N / 32, kb = item / nblk, nb = item % nblk, k0 = 64 * kb, n0 = 32 * nb;
    const int c = lane & 7;
    float wv_[32];
#pragma unroll
    for (int i = 0; i < 32; ++i) wv_[i] = W[(size_t)(k0 + 2 * i + (lane >> 5)) * N + n0 + (lane & 31)];
    f32x4 ga = {1.f, 1.f, 1.f, 1.f}, gb = {1.f, 1.f, 1.f, 1.f};
    if (HASG) { ga = *(const f32x4*)(gk + k0 + 8 * c); gb = *(const f32x4*)(gk + k0 + 8 * c + 4); }
#pragma unroll
    for (int i = 0; i < 32; ++i) scr[(2 * i + (lane >> 5)) * 33 + (lane & 31)] = wv_[i];
    LDS_WAIT(); asm volatile("" ::: "memory");
#pragma unroll
    for (int j = 0; j < 4; ++j) { const int n = (lane >> 3) + 8 * j; const LAS float* s = scr + (8 * c) * 33 + n;
        v4u o; o.x = pk2(s[0 * 33] * ga.x, s[1 * 33] * ga.y); o.y = pk2(s[2 * 33] * ga.z, s[3 * 33] * ga.w); o.z = pk2(s[4 * 33] * gb.x, s[5 * 33] * gb.y); o.w = pk2(s[6 * 33] * gb.z, s[7 * 33] * gb.w);
        *(GAS v4u*)(WT + (size_t)(row_off + n0 + n) * K + k0 + 8 * c) = o; }
    LDS_WAIT(); asm volatile("" ::: "memory");
}
__device__ __forceinline__ void conv_rows_fp8(const float* src, unsigned char* dst, float* sc, int gw, int ngw, int lane) {
    for (int r0 = 4 * gw; r0 < 16384; r0 += 4 * ngw) {
        f32x4 v[4][4]; float mx[4];
#pragma unroll
        for (int q = 0; q < 4; ++q) { const f32x4* p = (const f32x4*)(src + (size_t)(r0 + q) * 1024) + 4 * lane;
#pragma unroll
            for (int j = 0; j < 4; ++j) v[q][j] = p[j]; }
#pragma unroll
        for (int q = 0; q < 4; ++q) { float m = 0.f;
#pragma unroll
            for (int j = 0; j < 4; ++j) m = fmaxf(fmaxf(m, fmaxf(fabsf(v[q][j].x), fabsf(v[q][j].y))), fmaxf(fabsf(v[q][j].z), fabsf(v[q][j].w)));
            mx[q] = wave_max(m); }
#pragma unroll
        for (int q = 0; q < 4; ++q) { const float s = mx[q] > 0.f ? 448.0f / mx[q] : 1.0f; v4u o4;
#pragma unroll
            for (int j = 0; j < 4; ++j) { int w = 0; w = __builtin_amdgcn_cvt_pk_fp8_f32(v[q][j].x * s, v[q][j].y * s, w, false); w = __builtin_amdgcn_cvt_pk_fp8_f32(v[q][j].z * s, v[q][j].w * s, w, true); o4[j] = (unsigned)w; }
            *(v4u*)(dst + (size_t)(lane >> 3) * SLICE_BYTES + (size_t)(r0 + q) * 128 + 16 * (lane & 7)) = o4;
            if (lane == 0) sc[r0 + q] = mx[q] > 0.f ? mx[q] * (1.0f / 448.0f) : 1.0f; }
    }
}
__device__ __forceinline__ unsigned pack_i8x4(float a, float b, float c2, float d2) {
    const int ia = __float2int_rn(a), ib = __float2int_rn(b), ic = __float2int_rn(c2), id = __float2int_rn(d2);
    return ((unsigned)ia & 0xffu) | (((unsigned)ib & 0xffu) << 8) | (((unsigned)ic & 0xffu) << 16) | ((unsigned)id << 24);
}
__device__ __forceinline__ void conv_rows_i8(const float* src, unsigned char* dst, float* sc, int gw, int ngw, int lane, const float* gain) {
    f32x4 gf[4];
#pragma unroll
    for (int j = 0; j < 4; ++j) gf[j] = ((const f32x4*)gain + 4 * lane)[j];
    for (int r0 = 4 * gw; r0 < 16384; r0 += 4 * ngw) {
        f32x4 v[4][4]; float mx[4];
#pragma unroll
        for (int q = 0; q < 4; ++q) { const f32x4* p = (const f32x4*)(src + (size_t)(r0 + q) * 1024) + 4 * lane;
#pragma unroll
            for (int j = 0; j < 4; ++j) v[q][j] = p[j] * gf[j]; }
#pragma unroll
        for (int q = 0; q < 4; ++q) { float m = 0.f;
#pragma unroll
            for (int j = 0; j < 4; ++j) m = fmaxf(fmaxf(m, fmaxf(fabsf(v[q][j].x), fabsf(v[q][j].y))), fmaxf(fabsf(v[q][j].z), fabsf(v[q][j].w)));
            mx[q] = wave_max(m); }
#pragma unroll
        for (int q = 0; q < 4; ++q) { const float s = mx[q] > 0.f ? 127.0f / mx[q] : 1.0f; v4u o4;
#pragma unroll
            for (int j = 0; j < 4; ++j) o4[j] = pack_i8x4(v[q][j].x * s, v[q][j].y * s, v[q][j].z * s, v[q][j].w * s);
            *(v4u*)(dst + (size_t)(lane >> 3) * SLICE_BYTES + (size_t)(r0 + q) * 128 + 16 * (lane & 7)) = o4;
            if (lane == 0) sc[r0 + q] = mx[q] > 0.f ? mx[q] * (1.0f / 127.0f) : 1.0f; }
    }
}
__device__ __forceinline__ void norm_rows(const float* src, const float* gain, bf16* dst, float* copy_dst, int nrows, int gw, int ngw, int lane) {
    f32x4 gg4[4];
#pragma unroll
    for (int j = 0; j < 4; ++j) gg4[j] = ((const f32x4*)gain + lane)[64 * j];
    f32x4 v[4];
    if (gw < nrows) {
#pragma unroll
        for (int j = 0; j < 4; ++j) v[j] = ((const f32x4*)(src + (size_t)gw * D) + lane)[64 * j]; }
    for (int m = gw; m < nrows; m += ngw) {
        const int mn = (m + ngw < nrows) ? m + ngw : m;
        f32x4 vn[4];
#pragma unroll
        for (int j = 0; j < 4; ++j) vn[j] = ((const f32x4*)(src + (size_t)mn * D) + lane)[64 * j];
        KEEP4(v[0], v[1], v[2], v[3]);
        float s = 0.f;
#pragma unroll
        for (int j = 0; j < 4; ++j) s += (v[j].x * v[j].x + v[j].y * v[j].y) + (v[j].z * v[j].z + v[j].w * v[j].w);
        const float rs = rsqrtf(wave_sum(s) * (1.f / D) + EPS);
        if (copy_dst) { f32x4* cr = (f32x4*)(copy_dst + (size_t)m * D) + lane;
#pragma unroll
            for (int j = 0; j < 4; ++j) cr[64 * j] = v[j]; }
        v2u* o = (v2u*)(dst + (size_t)m * D) + lane;
#pragma unroll
        for (int j = 0; j < 4; ++j) { const f32x4 gg = gg4[j]; v2u w; w.x = pk2(v[j].x * rs * gg.x, v[j].y * rs * gg.y); w.y = pk2(v[j].z * rs * gg.z, v[j].w * rs * gg.w); o[64 * j] = w; }
#pragma unroll
        for (int j = 0; j < 4; ++j) v[j] = vn[j];
    }
}
__device__ __forceinline__ void rotary_tables(const Frame& F0) {
    PH_BEGIN; const Frame F = frame_local(F0);
    if (blockIdx.x == 0 && F.tid < 64) { const double f = exp2(-(double)F.tid * (2.0 / 128.0) * 13.287712379549449) * 0.15915494309189535; const double f128 = 128.0 * f;
        WSP(float, WS_COS)[F.tid] = (float)f; WSP(float, WS_COS)[64 + F.tid] = (float)(f128 - floor(f128)); }
    {
        const int gw = F.vcu * NWAVES + F.wave, ngw = F.G * NWAVES, lane = F.lane; const float* src = INP(I_X); bf16* dst = WSP(bf16, WS_XN); ss_t* ss0 = WSP(ss_t, WS_SS0);
        f32x4 v[4];
        if (gw < T) {
#pragma unroll
            for (int j = 0; j < 4; ++j) v[j] = ((const f32x4*)(src + (size_t)gw * D) + lane)[64 * j]; }
        for (int m = gw; m < T; m += ngw) {
            const int mn = (m + ngw < T) ? m + ngw : m; f32x4 vn[4];
#pragma unroll
            for (int j = 0; j < 4; ++j) vn[j] = ((const f32x4*)(src + (size_t)mn * D) + lane)[64 * j];
            KEEP4(v[0], v[1], v[2], v[3]);
            float s = 0.f;
#pragma unroll
            for (int j = 0; j < 4; ++j) s += (v[j].x * v[j].x + v[j].y * v[j].y) + (v[j].z * v[j].z + v[j].w * v[j].w);
            s = wave_sum(s);
            v2u* o = (v2u*)(dst + (size_t)m * D) + lane;
#pragma unroll
            for (int j = 0; j < 4; ++j) { v2u w; w.x = pk2(v[j].x, v[j].y); w.y = pk2(v[j].z, v[j].w); o[64 * j] = w; }
            if (lane == 0) ss0[m] = ss_fix(s);
#pragma unroll
            for (int j = 0; j < 4; ++j) v[j] = vn[j];
        }
    }
}
__device__ __forceinline__ void phase_prologue(const Frame& F0, int l) {
    PH_BEGIN; const Frame F = frame_local(F0);
    LAS float* scr = (LAS float*)(F.lds + F.wave * 16384);
    const int gw = F.vcu * NWAVES + F.wave, NGW = F.G * NWAVES;
    constexpr int I_IN = 16 * (INC / 32), I_SQ = 16 * 32, I_LRU = 8;
    constexpr int NITEMS = I_IN + 6 * I_SQ + 16 * I_LRU;
    for (int it = gw; it < NITEMS; it += NGW) {
        int r = it;
        if (r < I_IN) { p0_transpose_item<true>(INP(I_WIN) + (size_t)l * D * INC, D, INC, WSP(bf16, WS_WIN), 0, scr, r, F.lane, INP(I_GMIX) + l * D); continue; } r -= I_IN;
#define SQ_ITEM(idx, off) if (r < I_SQ) { p0_transpose_item<false>(INP(idx) + (size_t)l * D * D, D, D, WSP(bf16, off), 0, scr, r, F.lane); continue; } r -= I_SQ;
        SQ_ITEM(I_WRET, WS_WRET) SQ_ITEM(I_WRNN, WS_WRNN) SQ_ITEM(I_WMIX, WS_WMIX) SQ_ITEM(I_WXK, WS_WXK) SQ_ITEM(I_WXV, WS_WXV) SQ_ITEM(I_WXO, WS_WXO)
#undef SQ_ITEM
        { const int blk = r / I_LRU, sub = r % I_LRU;
          const float* src = INP(blk < 8 ? I_LWA : I_LWX) + (size_t)l * 8 * 128 * 128 + (size_t)(blk & 7) * 128 * 128;
          bf16* dst = WSP(bf16, blk < 8 ? WS_LWA : WS_LWX) + (size_t)(blk & 7) * 128 * 128;
          p0_transpose_item<false>(src, 128, 128, dst, 0, scr, sub, F.lane); }
    }
    const size_t gt = (size_t)F.vcu * NTHR + F.tid, GN = (size_t)F.G * NTHR;
    conv_rows_i8(INP(I_PU) + (size_t)l * 16384 * 1024, WSP(unsigned char, WS_PU8), WSP(float, WS_SCU), gw, NGW, F.lane, INP(I_GFFN) + l * D);
    conv_rows_fp8(INP(I_PV) + (size_t)l * 16384 * 1024, WSP(unsigned char, (l & 1) ? WS_PV8B : WS_PV8), WSP(float, WS_SCV), gw, NGW, F.lane);
    norm_rows(INP(I_MEM), INP(I_GMEM) + l * D, WSP(bf16, WS_MEMN), nullptr, 256, gw, NGW, F.lane);
    for (size_t i = gt; i < (size_t)T; i += GN) { WSP(ss_t, WS_SSA)[i] = 0ull; WSP(ss_t, WS_SSB)[i] = 0ull; WSP(ss_t, WS_SSC)[(size_t)l * T + i] = 0ull; }
}

__device__ __forceinline__ float sigm_fast(float x) { return __builtin_amdgcn_rcpf(1.0f + __builtin_amdgcn_exp2f(-1.4426950408889634f * x)); }
constexpr int RS_QK = 288, RS_V = 544, R_QS = 0, R_KS = 36864, R_VS = 73728, R_RED = 143360;
struct RotIn { v4u xa[2], xb[2]; };
struct CsIn { f32x4 c0[2], c1[2], s0[2], s1[2]; };
__device__ __forceinline__ void rot_load(RotIn& r, const bf16* src, int tid) {
#pragma unroll
    for (int rep = 0; rep < 2; ++rep) { const int it = tid + rep * NTHR; const bf16* rp = src + (size_t)(it >> 3) * 1024 + 8 * (it & 7); r.xa[rep] = *(const v4u*)rp; r.xb[rep] = *(const v4u*)(rp + 64); }
}
struct FrIn { f32x4 f[2], g[2]; int pos[2]; };
__device__ __forceinline__ void fr_load(FrIn& r, const float* fr, const int* posb, int tid) {
    const int p8 = tid & 7;
    r.f[0] = *(const f32x4*)(fr + 8 * p8); r.f[1] = *(const f32x4*)(fr + 8 * p8 + 4); r.g[0] = *(const f32x4*)(fr + 64 + 8 * p8); r.g[1] = *(const f32x4*)(fr + 64 + 8 * p8 + 4);
#pragma unroll
    for (int rep = 0; rep < 2; ++rep) r.pos[rep] = posb[(tid + rep * NTHR) >> 3];
}
__device__ __forceinline__ void cs_make(CsIn& r, const FrIn& fi) {
#pragma unroll
    for (int rep = 0; rep < 2; ++rep) { const float hi = (float)(fi.pos[rep] >> 7), lo = (float)(fi.pos[rep] & 127);
#pragma unroll
        for (int w = 0; w < 4; ++w) {
            const float r0 = __builtin_amdgcn_fractf(hi * fi.g[0][w]) + lo * fi.f[0][w], r1 = __builtin_amdgcn_fractf(hi * fi.g[1][w]) + lo * fi.f[1][w];
            r.c0[rep][w] = __builtin_amdgcn_cosf(r0); r.s0[rep][w] = __builtin_amdgcn_sinf(r0); r.c1[rep][w] = __builtin_amdgcn_cosf(r1); r.s1[rep][w] = __builtin_amdgcn_sinf(r1); } }
}
#define KEEP_FR(r) do { KEEP4((r).f[0], (r).f[1], (r).g[0], (r).g[1]); KEEP2((r).pos[0], (r).pos[1]); } while (0)
__device__ __forceinline__ void v_load(v4u (&t8)[8], const bf16* src, int tid) {
#pragma unroll
    for (int rep = 0; rep < 8; ++rep) { const int it = tid + rep * NTHR; t8[rep] = *(const v4u*)(src + (size_t)(it >> 5) * 1024 + 8 * (it & 31)); }
}
__device__ __forceinline__ void v_store(LAS unsigned char* dst, const v4u (&t8)[8], int tid) {
#pragma unroll
    for (int rep = 0; rep < 8; ++rep) { const int it = tid + rep * NTHR; *(LAS v4u*)(dst + (it >> 5) * RS_V + 16 * (it & 31)) = t8[rep]; }
}
template <int MODE>
__device__ __forceinline__ void rot_store(LAS unsigned char* dst, const RotIn& r, const CsIn& cs, float log2g, int tid) {
#pragma unroll
    for (int rep = 0; rep < 2; ++rep) {
        const int it = tid + rep * NTHR, j = it >> 3, p8 = it & 7;
        const v4u xa = r.xa[rep], xb = r.xb[rep]; const f32x4 c0 = cs.c0[rep], c1 = cs.c1[rep], s0 = cs.s0[rep], s1 = cs.s1[rep];
        float sc = (MODE == 0) ? 1.0f : 0.08838834764831845f;
        if (MODE == 2) sc *= __builtin_amdgcn_exp2f((float)(127 - j) * log2g);
        v4u o1, o2;
#pragma unroll
        for (int w = 0; w < 4; ++w) {
            const float a_lo = bflo(xa[w]), a_hi = bfhi(xa[w]), b_lo = bflo(xb[w]), b_hi = bfhi(xb[w]);
            const float cl = (w < 2) ? c0[2 * w] : c1[2 * w - 4], ch = (w < 2) ? c0[2 * w + 1] : c1[2 * w - 3];
            const float sl = (w < 2) ? s0[2 * w] : s1[2 * w - 4], sh = (w < 2) ? s0[2 * w + 1] : s1[2 * w - 3];
            o1[w] = pk2((a_lo * cl - b_lo * sl) * sc, (a_hi * ch - b_hi * sh) * sc);
            o2[w] = pk2((b_lo * cl + a_lo * sl) * sc, (b_hi * ch + a_hi * sh) * sc);
        }
        *(LAS v4u*)(dst + j * RS_QK + 16 * p8) = o1;
        *(LAS v4u*)(dst + j * RS_QK + 128 + 16 * p8) = o2;
    }
}
#define KEEP_ROT(r) KEEP4((r).xa[0], (r).xa[1], (r).xb[0], (r).xb[1])
__device__ __forceinline__ float ret_log2g(int h) { return log2f(1.0f - exp2f(-5.0f - (float)h)); }

__device__ __forceinline__ void r1_unit(const Frame& F0, int c, int h) {
    PH_BEGIN; const Frame F = frame_local(F0);
    const int tid = F.tid, wid = F.wave, lane = F.lane, g = lane >> 4, l15 = lane & 15, q = l15 >> 2, p = l15 & 3;
    const int t0 = c * 128;
    LAS unsigned char* Ks = F.lds + R_KS; LAS unsigned char* Vs = F.lds + R_VS;
    const float log2g = ret_log2g(h);
    {   RotIn rk; CsIn cs; FrIn fi; v4u t8[8];
        fr_load(fi, WSP(float, WS_COS), (const int*)INP(I_POS) + t0, tid); rot_load(rk, WSP(bf16, WS_Z) + (size_t)t0 * 1024 + 512 + h * 128, tid);
        v_load(t8, WSP(bf16, WS_Z + ZSTRIDE) + (size_t)t0 * 1024 + h * 256, tid);
        KEEP_FR(fi); cs_make(cs, fi); KEEP_ROT(rk); KEEP8(t8);
        rot_store<2>(Ks, rk, cs, log2g, tid); v_store(Vs, t8, tid); }
    __syncthreads();
    const int we = wid >> 1, wd = wid & 1;
    f32x4 acc[4][4];
#pragma unroll
    for (int m = 0; m < 4; ++m)
#pragma unroll
        for (int n = 0; n < 4; ++n) acc[m][n] = (f32x4){0.f, 0.f, 0.f, 0.f};
#pragma unroll
    for (int ks = 0; ks < 4; ++ks) {
        bf16x8 av[4], bv[4];
#pragma unroll
        for (int m = 0; m < 4; ++m) av[m] = lds_trfrag(Vs, RS_V, 32 * ks + 8 * g, 64 * we + 16 * m, q, p);
#pragma unroll
        for (int n = 0; n < 4; ++n) bv[n] = lds_trfrag(Ks, RS_QK, 32 * ks + 8 * g, 64 * wd + 16 * n, q, p);
#pragma unroll
        for (int m = 0; m < 4; ++m)
#pragma unroll
            for (int n = 0; n < 4; ++n) acc[m][n] = MFMA16(av[m], bv[n], acc[m][n]);
    }
    bf16* kv = WSP(bf16, WS_KV) + (size_t)(c * 4 + h) * 32768;
    __syncthreads();
    LAS unsigned char* OT = F.lds;
#pragma unroll
    for (int m = 0; m < 4; ++m)
#pragma unroll
        for (int n = 0; n < 4; ++n)
#pragma unroll
            for (int r = 0; r < 4; ++r) *(LAS bf16*)(OT + (64 * we + 16 * m + 4 * g + r) * 272 + (64 * wd + 16 * n + l15) * 2) = (bf16)f2bf(acc[m][n][r]);
    __syncthreads();
#pragma unroll
    for (int i = 0; i < 8; ++i) { const int idx = tid + NTHR * i, row = idx >> 4, pc = idx & 15; *(v4u*)(kv + (size_t)row * 128 + 8 * pc) = *(const LAS v4u*)(OT + row * 272 + 16 * pc); }
    __syncthreads();
}

__device__ __forceinline__ void r2_scan(const Frame& F0) {
    PH_BEGIN; const Frame F = frame_local(F0);
    if (F.tid < 256)
    for (int p = blockIdx.x * 256 + F.tid; p < 65536; p += F.G * 256) {
        const int h = p >> 14; const float g128 = exp2f(128.0f * ret_log2g(h));
        unsigned* pp = WSP(unsigned, WS_KV) + p; float s0 = 0.f, s1 = 0.f;
        unsigned va[32], vb[32];
#pragma unroll
        for (int i = 0; i < 32; ++i) va[i] = pp[(size_t)i * 65536];
#pragma unroll
        for (int cb = 0; cb < 128; cb += 64) {
#pragma unroll
            for (int i = 0; i < 32; ++i) vb[i] = pp[(size_t)(cb + 32 + i) * 65536];
#pragma unroll
            for (int i = 0; i < 32; ++i) { const float k0 = bflo(va[i]), k1 = bfhi(va[i]); pp[(size_t)(cb + i) * 65536] = pk2(s0, s1); s0 = g128 * s0 + k0; s1 = g128 * s1 + k1; }
            if (cb + 64 < 128) {
#pragma unroll
                for (int i = 0; i < 32; ++i) va[i] = pp[(size_t)(cb + 64 + i) * 65536]; }
#pragma unroll
            for (int i = 0; i < 32; ++i) { const float k0 = bflo(vb[i]), k1 = bfhi(vb[i]); pp[(size_t)(cb + 32 + i) * 65536] = pk2(s0, s1); s0 = g128 * s0 + k0; s1 = g128 * s1 + k1; }
        }
    }
}

template <bool DRY>
__device__ __forceinline__ void r3_unit(const Frame& F0, int c, int h) {
    PH_BEGIN; const Frame F = frame_local(F0);
    const int tid = F.tid, wid = F.wave, lane = F.lane, g = lane >> 4, l15 = lane & 15, q = l15 >> 2, p = l15 & 3;
    const int t0 = c * 128;
    LAS unsigned char* Qs = F.lds + R_QS; LAS unsigned char* Ks = F.lds + R_KS; LAS unsigned char* Vs = F.lds + R_VS; LAS float* RED = (LAS float*)(F.lds + R_RED);
    const float log2g = ret_log2g(h);
    const int wr = wid >> 2, wc = wid & 3;
    const bf16* sp = WSP(bf16, WS_KV) + (size_t)(c * 4 + h) * 32768 + (size_t)(64 * wc + l15) * 128 + 8 * g;
    bf16x8 bsr[4][4];
#pragma unroll
    for (int ks = 0; ks < 4; ++ks)
#pragma unroll
        for (int n = 0; n < 4; ++n) bsr[ks][n] = *(const bf16x8*)(sp + n * 16 * 128 + 32 * ks);
    {   RotIn rq, rk; CsIn cs; FrIn fi; v4u t8[8];
        fr_load(fi, WSP(float, WS_COS), (const int*)INP(I_POS) + t0, tid); rot_load(rq, WSP(bf16, WS_Z) + (size_t)t0 * 1024 + h * 128, tid); rot_load(rk, WSP(bf16, WS_Z) + (size_t)t0 * 1024 + 512 + h * 128, tid);
        v_load(t8, WSP(bf16, WS_Z + ZSTRIDE) + (size_t)t0 * 1024 + h * 256, tid);
        KEEP_FR(fi); cs_make(cs, fi); KEEP_ROT(rq); KEEP_ROT(rk); KEEP8(t8);
        rot_store<0>(Qs, rq, cs, log2g, tid); rot_store<1>(Ks, rk, cs, log2g, tid); v_store(Vs, t8, tid); }
    __syncthreads();
    f32x4 accO[4][4], accS[4][2];
#pragma unroll
    for (int m = 0; m < 4; ++m) {
#pragma unroll
        for (int n = 0; n < 4; ++n) accO[m][n] = (f32x4){0.f, 0.f, 0.f, 0.f};
        accS[m][0] = (f32x4){0.f, 0.f, 0.f, 0.f}; accS[m][1] = (f32x4){0.f, 0.f, 0.f, 0.f}; }
#pragma unroll
    for (int ks = 0; ks < 4; ++ks) {
        bf16x8 av[4], bk[2];
#pragma unroll
        for (int m = 0; m < 4; ++m) av[m] = lds_rowfrag(Qs, RS_QK, 64 * wr + 16 * m + l15, 32 * ks + 8 * g);
#pragma unroll
        for (int n = 0; n < 2; ++n) bk[n] = lds_rowfrag(Ks, RS_QK, 32 * wc + 16 * n + l15, 32 * ks + 8 * g);
#pragma unroll
        for (int m = 0; m < 4; ++m) {
#pragma unroll
            for (int n = 0; n < 4; ++n) accO[m][n] = MFMA16(av[m], bsr[ks][n], accO[m][n]);
#pragma unroll
            for (int n = 0; n < 2; ++n) accS[m][n] = MFMA16(av[m], bk[n], accS[m][n]);
        }
        asm volatile("" ::: "memory");
    }
    bf16* gret = WSP(bf16, WS_Z + 2 * ZSTRIDE) + (size_t)t0 * 1024 + h * 256;
    v4u gvr[8];
#pragma unroll
    for (int i = 0; i < 8; ++i) { const int cidx = tid + NTHR * i; gvr[i] = *(const v4u*)(gret + (size_t)(cidx >> 5) * 1024 + 8 * (cidx & 31)); }
#pragma unroll
    for (int m = 0; m < 4; ++m)
#pragma unroll
        for (int r = 0; r < 4; ++r) { const float qd = __builtin_amdgcn_exp2f((float)(64 * wr + 16 * m + 4 * g + r + 1) * log2g);
#pragma unroll
            for (int n = 0; n < 4; ++n) accO[m][n][r] *= qd; }
    __syncthreads();
    LAS unsigned char* Ps = Ks;
#pragma unroll
    for (int m = 0; m < 4; ++m)
#pragma unroll
        for (int n = 0; n < 2; ++n)
#pragma unroll
            for (int r = 0; r < 4; ++r) { const int i = 64 * wr + 16 * m + 4 * g + r, j = 32 * wc + 16 * n + l15;
                const float dm = (i >= j) ? __builtin_amdgcn_exp2f((float)(i - j) * log2g) : 0.f;
                *(LAS bf16*)(Ps + i * RS_QK + j * 2) = (bf16)f2bf(accS[m][n][r] * dm); }
    __syncthreads();
#pragma unroll 1
    for (int ks = 0; ks < 4; ++ks) {
        bf16x8 av[4], bv[4];
#pragma unroll
        for (int m = 0; m < 4; ++m) av[m] = lds_rowfrag(Ps, RS_QK, 64 * wr + 16 * m + l15, 32 * ks + 8 * g);
#pragma unroll
        for (int n = 0; n < 4; ++n) bv[n] = lds_trfrag(Vs, RS_V, 32 * ks + 8 * g, 64 * wc + 16 * n, q, p);
#pragma unroll
        for (int m = 0; m < 4; ++m)
#pragma unroll
            for (int n = 0; n < 4; ++n) accO[m][n] = MFMA16(av[m], bv[n], accO[m][n]);
    }
#pragma unroll
    for (int m = 0; m < 4; ++m)
#pragma unroll
        for (int r = 0; r < 4; ++r) { float s1 = 0.f, s2 = 0.f;
#pragma unroll
            for (int n = 0; n < 4; ++n) { const float v = accO[m][n][r]; s1 += v; s2 += v * v; }
            s1 = row_sum(s1); s2 = row_sum(s2);
            if (l15 == 0) { const int row = 64 * wr + 16 * m + 4 * g + r; RED[(row * 4 + wc) * 2] = s1; RED[(row * 4 + wc) * 2 + 1] = s2; } }
    __syncthreads();
    LAS unsigned char* OT = F.lds + R_QS;
#pragma unroll
    for (int m = 0; m < 4; ++m)
#pragma unroll
        for (int r = 0; r < 4; ++r) { const int row = 64 * wr + 16 * m + 4 * g + r;
            const f32x4 ra = *(const LAS f32x4*)(RED + row * 8), rb = *(const LAS f32x4*)(RED + row * 8 + 4);
            const float s1 = (ra[0] + ra[2]) + (rb[0] + rb[2]), s2 = (ra[1] + ra[3]) + (rb[1] + rb[3]);
            const float mu = s1 * (1.f / 256.f), var = fmaxf(s2 * (1.f / 256.f) - mu * mu, 0.f), rstd = rsqrtf(var + EPS);
#pragma unroll
            for (int n = 0; n < 4; ++n) *(LAS bf16*)(OT + row * 528 + (64 * wc + 16 * n + l15) * 2) = (bf16)f2bf((accO[m][n][r] - mu) * rstd); }
    __syncthreads();
#pragma unroll
    for (int i = 0; i < 8; ++i) { const int cidx = tid + NTHR * i, row = cidx >> 5, ch = cidx & 31;
        const v4u ov = *(const LAS v4u*)(OT + row * 528 + 16 * ch); v4u* gp = (v4u*)(gret + (size_t)row * 1024 + 8 * ch); const v4u gv = gvr[i]; v4u res;
#pragma unroll
        for (int w = 0; w < 4; ++w) { const unsigned ow = ov[w], gw_ = gv[w]; const float g0 = bflo(gw_), g1 = bfhi(gw_);
            res[w] = pk2(bflo(ow) * g0 * sigm_fast(g0), bfhi(ow) * g1 * sigm_fast(g1)); }
        if (!DRY || res[0] == 0x12345678u) *gp = res; }
    __syncthreads();
}

constexpr int L_XCF = 0, L_AF = 33792, L_XCB = 67584, L_SEG = 67584 + 18432, L_CAR = L_SEG + 4096, L_CW = L_CAR + 1024, L_LAF = L_CW + 2560;
__device__ __forceinline__ float gelu_tanh_fast(float x) { const float z = 0.7978845608028654f * (x + 0.044715f * x * x * x); return x * (1.0f - __builtin_amdgcn_rcpf(1.0f + __builtin_amdgcn_exp2f(2.885390081777927f * z))); }
#define LRU_LAB(unit) (WSP(v4u, ((unit) < 128 ? WS_LA : WS_LB)) + (size_t)((unit) & 127) * (8 * NTHR * 4))
__device__ __forceinline__ void lru_strip_agg(const Frame& F0, int l, int sg, int nb) {
    PH_BEGIN; const Frame F = frame_local(F0);
    const int tid = F.tid, wid = F.wave, lane = F.lane, g = lane >> 4, l15 = lane & 15;
    const int c0 = nb * 128;
    LAS float* XCF = (LAS float*)(F.lds + L_XCF); LAS float* AF = (LAS float*)(F.lds + L_AF); LAS unsigned char* XCB = F.lds + L_XCB; LAS float* SEG = (LAS float*)(F.lds + L_SEG);
    LAS float* CW = (LAS float*)(F.lds + L_CW); LAS unsigned* ABW = (LAS unsigned*)(F.lds + L_LAF);
    const int wt = wid >> 2, wd = wid & 3;
    bf16x8 fba[4][2], fbx[4][2];
    {   const bf16* wa = WSP(bf16, WS_LWA) + (size_t)nb * 16384 + (size_t)(32 * wd + l15) * 128 + 8 * g;
        const bf16* wx = WSP(bf16, WS_LWX) + (size_t)nb * 16384 + (size_t)(32 * wd + l15) * 128 + 8 * g;
#pragma unroll
        for (int ks = 0; ks < 4; ++ks)
#pragma unroll
            for (int n = 0; n < 2; ++n) { fba[ks][n] = *(const bf16x8*)(wa + n * 16 * 128 + 32 * ks); fbx[ks][n] = *(const bf16x8*)(wx + n * 16 * 128 + 32 * ks); } }
    float bav[2], bxv[2], spv[2];
#pragma unroll
    for (int n = 0; n < 2; ++n) { const int ch = l * 1024 + c0 + 32 * wd + 16 * n + l15;
        bav[n] = -1.4426950408889634f * INP(I_LBA)[ch]; bxv[n] = -1.4426950408889634f * INP(I_LBX)[ch];
        spv[n] = -11.541560327111707f * log1pf(expf(-INP(I_LAM)[ch])); }
    for (int i = tid; i < 640; i += NTHR) CW[i] = (i < 512) ? INP(I_CONVW)[(size_t)(l * 4 + (i >> 7)) * 1024 + c0 + (i & 127)] : INP(I_CONVB)[l * 1024 + c0 + (i - 512)];
    const int sd = tid & 127, sseg = tid >> 7;
    float Astrip = 1.f, Bstrip = 0.f;
    const int* pos = (const int*)INP(I_POS);
    const bf16* xr = WSP(bf16, WS_Z + 3 * ZSTRIDE);
    v4u* labo = LRU_LAB(sg * 8 + nb) + tid;
    v4u xq[4][2];
    {   const int t = tid >> 3, cc = c0 + 16 * (tid & 7);
#pragma unroll
        for (int k = 0; k < 4; ++k) { const int tt = max(sg * 512 + t - 3 + k, 0); xq[k][0] = *(const v4u*)(xr + (size_t)tt * 1024 + cc); xq[k][1] = *(const v4u*)(xr + (size_t)tt * 1024 + cc + 8); } }
    __syncthreads();
#pragma unroll 1
    for (int tl = 0; tl < 8; ++tl) {
        const int t0 = sg * 512 + tl * 64;
        typedef int v4i_t __attribute__((ext_vector_type(4)));
        v4i_t posv[2];
#pragma unroll
        for (int m = 0; m < 2; ++m) posv[m] = *(const v4i_t*)(pos + t0 + 32 * wt + 16 * m + 4 * g);
        v4u xn[4][2];
        {   const int t = tid >> 3, cc = c0 + 16 * (tid & 7), tb = sg * 512 + min(tl + 1, 7) * 64;
#pragma unroll
            for (int k = 0; k < 4; ++k) { const int tt = tb + t - 3 + k; xn[k][0] = *(const v4u*)(xr + (size_t)tt * 1024 + cc); xn[k][1] = *(const v4u*)(xr + (size_t)tt * 1024 + cc + 8); } }
        {
            const int t = tid >> 3, cg = tid & 7;
            f32x4 acc4[4];
#pragma unroll
            for (int i = 0; i < 4; ++i) acc4[i] = *(const LAS f32x4*)(CW + 512 + 16 * cg + 4 * i);
#pragma unroll
            for (int k = 0; k < 4; ++k) { const int tt = t0 + t - 3 + k;
                if (tt >= 0) { const v4u x0 = xq[k][0], x1 = xq[k][1];
                    const LAS float* wp = CW + k * 128 + 16 * cg;
                    const f32x4 w0 = *(const LAS f32x4*)wp, w1 = *(const LAS f32x4*)(wp + 4), w2 = *(const LAS f32x4*)(wp + 8), w3 = *(const LAS f32x4*)(wp + 12);
                    acc4[0] += w0 * (f32x4){bflo(x0.x), bfhi(x0.x), bflo(x0.y), bfhi(x0.y)};
                    acc4[1] += w1 * (f32x4){bflo(x0.z), bfhi(x0.z), bflo(x0.w), bfhi(x0.w)};
                    acc4[2] += w2 * (f32x4){bflo(x1.x), bfhi(x1.x), bflo(x1.y), bfhi(x1.y)};
                    acc4[3] += w3 * (f32x4){bflo(x1.z), bfhi(x1.z), bflo(x1.w), bfhi(x1.w)}; } }
#pragma unroll
            for (int i = 0; i < 4; ++i) *(LAS f32x4*)(XCF + t * 132 + 16 * cg + 4 * i) = acc4[i];
            v4u b0, b1; b0.x = pk2(acc4[0][0], acc4[0][1]); b0.y = pk2(acc4[0][2], acc4[0][3]); b0.z = pk2(acc4[1][0], acc4[1][1]); b0.w = pk2(acc4[1][2], acc4[1][3]);
            b1.x = pk2(acc4[2][0], acc4[2][1]); b1.y = pk2(acc4[2][2], acc4[2][3]); b1.z = pk2(acc4[3][0], acc4[3][1]); b1.w = pk2(acc4[3][2], acc4[3][3]);
            *(LAS v4u*)(XCB + t * RS_QK + 32 * cg) = b0; *(LAS v4u*)(XCB + t * RS_QK + 32 * cg + 16) = b1;
        }
        __syncthreads();
        if (tl > 0 && sseg == 3) {
            float h = 0.f, Ap = 1.f;
#pragma unroll
            for (int s = 0; s < 3; ++s) { const float sa = SEG[(s * 128 + sd) * 2], sb = SEG[(s * 128 + sd) * 2 + 1]; h = sa * h + sb; Ap *= sa; }
            const float pA = SEG[(3 * 128 + sd) * 2], pB = SEG[(3 * 128 + sd) * 2 + 1]; const float At = Ap * pA, Bt = pA * h + pB; Bstrip = At * Bstrip + Bt; Astrip *= At; }
        {
            f32x4 ga[2][2], gx[2][2];
#pragma unroll
            for (int m = 0; m < 2; ++m)
#pragma unroll
                for (int n = 0; n < 2; ++n) { ga[m][n] = (f32x4){0.f, 0.f, 0.f, 0.f}; gx[m][n] = (f32x4){0.f, 0.f, 0.f, 0.f}; }
#pragma unroll
            for (int ks = 0; ks < 4; ++ks) {
                bf16x8 av[2];
#pragma unroll
                for (int m = 0; m < 2; ++m) av[m] = lds_rowfrag(XCB, RS_QK, 32 * wt + 16 * m + l15, 32 * ks + 8 * g);
#pragma unroll
                for (int m = 0; m < 2; ++m)
#pragma unroll
                    for (int n = 0; n < 2; ++n) { ga[m][n] = MFMA16(av[m], fba[ks][n], ga[m][n]); gx[m][n] = MFMA16(av[m], fbx[ks][n], gx[m][n]); }
            }
#pragma unroll
            for (int m = 0; m < 2; ++m)
#pragma unroll
                for (int r = 0; r < 4; ++r) { const int t = 32 * wt + 16 * m + 4 * g + r; const bool rst = posv[m][r] == 0;
#pragma unroll
                    for (int n = 0; n < 2; ++n) { const int d = 32 * wd + 16 * n + l15;
                        const float gr = __builtin_amdgcn_rcpf(1.0f + __builtin_amdgcn_exp2f(__builtin_fmaf(ga[m][n][r], -1.4426950408889634f, bav[n])));
                        const float gi = __builtin_amdgcn_rcpf(1.0f + __builtin_amdgcn_exp2f(__builtin_fmaf(gx[m][n][r], -1.4426950408889634f, bxv[n])));
                        float la = gr * spv[n];
                        if (rst) la = -200.0f;
                        la = __builtin_bit_cast(float, cvt_pk_nv(la, 0.f) << 16);
                        const float av_ = __builtin_amdgcn_exp2f(la);
                        const float mult = __builtin_amdgcn_sqrtf(__builtin_fmaf(-av_, av_, 1.0f));
                        AF[t * 132 + d] = av_; ABW[t * 132 + d] = cvt_pk_nv(la, XCF[t * 132 + d] * gi * mult); } }
        }
        __syncthreads();
        {
            float A = 1.f, B = 0.f; unsigned wv[16];
#pragma unroll
            for (int k = 0; k < 16; ++k) { const int t = 16 * sseg + k; const float av_ = AF[t * 132 + sd]; wv[k] = ABW[t * 132 + sd]; B = av_ * B + __builtin_bit_cast(float, wv[k] & 0xffff0000u); A *= av_; }
#pragma unroll
            for (int j = 0; j < 4; ++j) labo[(size_t)(tl * 4 + j) * NTHR] = (v4u){wv[4 * j], wv[4 * j + 1], wv[4 * j + 2], wv[4 * j + 3]};
            SEG[(sseg * 128 + sd) * 2] = A; SEG[(sseg * 128 + sd) * 2 + 1] = B;
        }
#pragma unroll
        for (int k = 0; k < 4; ++k) { xq[k][0] = xn[k][0]; xq[k][1] = xn[k][1]; }
    }
    __syncthreads();
    if (sseg == 3) {
        float h = 0.f, Ap = 1.f;
#pragma unroll
        for (int s = 0; s < 3; ++s) { const float sa = SEG[(s * 128 + sd) * 2], sb = SEG[(s * 128 + sd) * 2 + 1]; h = sa * h + sb; Ap *= sa; }
        const float pA = SEG[(3 * 128 + sd) * 2], pB = SEG[(3 * 128 + sd) * 2 + 1]; const float At = Ap * pA, Bt = pA * h + pB; Bstrip = At * Bstrip + Bt; Astrip *= At;
        WSP(float, WS_AGGA)[(size_t)sg * 1024 + c0 + sd] = Astrip; WSP(float, WS_AGGB)[(size_t)sg * 1024 + c0 + sd] = Bstrip; }
    __syncthreads();
}
__device__ __forceinline__ void lru_final(const Frame& F0, int sg, int nb) {
    PH_BEGIN; const Frame F = frame_local(F0);
    const int tid = F.tid, c0 = nb * 128, sd = tid & 127, sseg = tid >> 7;
    LAS float* SEG = (LAS float*)(F.lds + L_SEG);
    LAS float* CAR = (LAS float*)(F.lds + L_SEG + 8192);
    bf16* yr = WSP(bf16, WS_Z + 4 * ZSTRIDE) + (size_t)(sg * 512 + 16 * sseg) * 1024 + c0 + sd;
    const v4u* labi = LRU_LAB(sg * 8 + nb) + tid;
    if (tid < 128) CAR[tid] = WSP(float, WS_HIN)[(size_t)sg * 1024 + c0 + tid];
    v4u cw[4]; bf16 yv[16];
#pragma unroll
    for (int j = 0; j < 4; ++j) cw[j] = labi[(size_t)j * NTHR];
#pragma unroll
    for (int k = 0; k < 16; ++k) yv[k] = yr[(size_t)k * 1024];
#pragma unroll 1
    for (int tl = 0; tl < 8; ++tl) {
        const int par = tl & 1, tn = min(tl + 1, 7);
        v4u nw[4]; bf16 yn[16];
#pragma unroll
        for (int j = 0; j < 4; ++j) nw[j] = labi[(size_t)(tn * 4 + j) * NTHR];
#pragma unroll
        for (int k = 0; k < 16; ++k) yn[k] = yr[(size_t)(tn * 64 + k) * 1024];
        float a_[16], b_[16]; float A = 1.f, B = 0.f;
#pragma unroll
        for (int k = 0; k < 16; ++k) { const unsigned w = cw[k >> 2][k & 3];
            a_[k] = __builtin_amdgcn_exp2f(__builtin_bit_cast(float, w << 16)); b_[k] = __builtin_bit_cast(float, w & 0xffff0000u); B = a_[k] * B + b_[k]; A *= a_[k]; }
        SEG[((par * 4 + sseg) * 128 + sd) * 2] = A; SEG[((par * 4 + sseg) * 128 + sd) * 2 + 1] = B;
        __syncthreads();
        float h = CAR[par * 128 + sd];
#pragma unroll
        for (int s = 0; s < 3; ++s) if (s < sseg) { const float sa = SEG[((par * 4 + s) * 128 + sd) * 2], sb = SEG[((par * 4 + s) * 128 + sd) * 2 + 1]; h = sa * h + sb; }
#pragma unroll
        for (int k = 0; k < 16; ++k) { h = a_[k] * h + b_[k]; yr[(size_t)(tl * 64 + k) * 1024] = (bf16)f2bf(h * gelu_tanh_fast(bf2f(yv[k]))); }
        if (sseg == 3) CAR[(par ^ 1) * 128 + sd] = h;
#pragma unroll
        for (int j = 0; j < 4; ++j) cw[j] = nw[j];
#pragma unroll
        for (int k = 0; k < 16; ++k) yv[k] = yn[k];
    }
    __syncthreads();
}
__device__ __forceinline__ void lru_carry(const Frame& F0) {
    PH_BEGIN; const Frame F = frame_local(F0);
    const int gw = blockIdx.x * NWAVES + F.wave, nw = F.G * NWAVES;
    for (int pr = gw; pr < 512; pr += nw) {
        const int ch = 2 * pr + (F.lane >> 5), s = F.lane & 31;
        float a = WSP(float, WS_AGGA)[(size_t)s * 1024 + ch], b = WSP(float, WS_AGGB)[(size_t)s * 1024 + ch];
#pragma unroll
        for (int d = 1; d < 32; d <<= 1) { const float ap = __shfl_up(a, d, 32), bp = __shfl_up(b, d, 32); if (s >= d) { b = a * bp + b; a = a * ap; } }
        const float hin = __shfl_up(b, 1, 32);
        WSP(float, WS_HIN)[(size_t)s * 1024 + ch] = (s == 0) ? 0.f : hin;
    }
}

__device__ __forceinline__ unsigned ordkey(float x) { const unsigned u = __builtin_bit_cast(unsigned, x); return (u & 0x80000000u) ? ~u : (u | 0x80000000u); }
__device__ __forceinline__ void sort16_desc(unsigned (&a)[16]) {
#define S16_CE(i, j) { const unsigned hi_ = max(a[i], a[j]), lo_ = min(a[i], a[j]); a[i] = hi_; a[j] = lo_; }
    S16_CE(0, 13) S16_CE(1, 12) S16_CE(2, 15) S16_CE(3, 14) S16_CE(4, 8) S16_CE(5, 6) S16_CE(7, 11) S16_CE(9, 10)
    S16_CE(0, 5) S16_CE(1, 7) S16_CE(2, 9) S16_CE(3, 4) S16_CE(6, 13) S16_CE(8, 14) S16_CE(10, 15) S16_CE(11, 12)
    S16_CE(0, 1) S16_CE(2, 3) S16_CE(4, 5) S16_CE(6, 8) S16_CE(7, 9) S16_CE(10, 11) S16_CE(12, 13) S16_CE(14, 15)
    S16_CE(0, 2) S16_CE(1, 3) S16_CE(4, 10) S16_CE(5, 11) S16_CE(6, 7) S16_CE(8, 9) S16_CE(12, 14) S16_CE(13, 15)
    S16_CE(1, 2) S16_CE(3, 12) S16_CE(4, 6) S16_CE(5, 7) S16_CE(8, 10) S16_CE(9, 11) S16_CE(13, 14)
    S16_CE(1, 4) S16_CE(2, 6) S16_CE(5, 8) S16_CE(7, 10) S16_CE(9, 13) S16_CE(11, 14)
    S16_CE(2, 4) S16_CE(3, 6) S16_CE(9, 12) S16_CE(11, 13)
    S16_CE(3, 5) S16_CE(6, 8) S16_CE(7, 9) S16_CE(10, 12)
    S16_CE(3, 4) S16_CE(5, 6) S16_CE(7, 8) S16_CE(9, 10) S16_CE(11, 12)
    S16_CE(6, 7) S16_CE(8, 9)
#undef S16_CE
}
__device__ __forceinline__ void merge_top16(unsigned (&a)[16], const unsigned (&b)[16]) {
#pragma unroll
    for (int i = 0; i < 16; ++i) a[i] = max(a[i], b[15 - i]);
#pragma unroll
    for (int lj = 3; lj >= 0; --lj)
#pragma unroll
        for (int i = 0; i < 16; ++i) { const int j = 1 << lj, l = i ^ j;
            if (l > i) { const unsigned hi = max(a[i], a[l]), lo = min(a[i], a[l]); a[i] = hi; a[l] = lo; } }
}
constexpr int TK_SC = 0, TK_KEYS = 132096;
__device__ __forceinline__ void topk_select(LAS unsigned char* ldsb, int tid, int t0, int h, unsigned short* idxb, float* gateb) {
    LAS float* SC = (LAS float*)(ldsb + TK_SC);
    LAS unsigned* KEYS = (LAS unsigned*)(ldsb + TK_KEYS);
    const int row = tid & 255, half = tid >> 8;
    unsigned keys[16];
    {   unsigned k1[16], k2[16], k3[16];
#pragma unroll
        for (int i = 0; i < 16; ++i) { const int n = half * 64 + i;
            keys[i] = (ordkey(SC[row * 129 + n]) & ~127u) | (unsigned)(127 - n); k1[i] = (ordkey(SC[row * 129 + n + 16]) & ~127u) | (unsigned)(127 - n - 16);
            k2[i] = (ordkey(SC[row * 129 + n + 32]) & ~127u) | (unsigned)(127 - n - 32); k3[i] = (ordkey(SC[row * 129 + n + 48]) & ~127u) | (unsigned)(127 - n - 48); }
        sort16_desc(keys); sort16_desc(k1); sort16_desc(k2); sort16_desc(k3);
        merge_top16(keys, k1); merge_top16(k2, k3); merge_top16(keys, k2);
    }
    if (half == 1) {
#pragma unroll
        for (int s = 0; s < 16; ++s) KEYS[s * 256 + row] = keys[s]; }
    __syncthreads();
    float val[16]; int id[16];
    if (half == 0) {
        {   unsigned ko[16];
#pragma unroll
            for (int s2 = 0; s2 < 16; ++s2) ko[s2] = KEYS[s2 * 256 + row];
            merge_top16(keys, ko); }
#pragma unroll
        for (int s = 0; s < 16; ++s) { id[s] = 127 - (int)(keys[s] & 127u); val[s] = SC[row * 129 + id[s]]; }
#pragma unroll
        for (int s = 0; s < 16; ++s) { SC[row * 129 + s] = val[s]; SC[row * 129 + 16 + s] = __builtin_bit_cast(float, id[s]); }
    }
    __syncthreads();
    if (tid < 128) {
        const LAS float* r1 = SC + tid * 129; const LAS float* r2 = SC + (128 + tid) * 129;
        float v1[16], v2[16];
#pragma unroll
        for (int s = 0; s < 16; ++s) { v1[s] = r1[s]; v2[s] = r2[s]; }
#define CKEY(a_, b_) ((ordkey(v1[a_] + v2[b_]) & ~255u) | (unsigned)(255 - ((a_) * 16 + (b_))))
        unsigned ck[16], c1[16], c2[16], c3[16];
#pragma unroll
        for (int b_ = 0; b_ < 16; ++b_) ck[b_] = CKEY(0, b_);
#pragma unroll
        for (int b_ = 0; b_ < 8; ++b_) c1[b_] = CKEY(1, b_);
#pragma unroll
        for (int b_ = 0; b_ < 5; ++b_) c1[8 + b_] = CKEY(2, b_);
        c1[13] = CKEY(5, 0); c1[14] = CKEY(5, 1); c1[15] = 0u;
#pragma unroll
        for (int b_ = 0; b_ < 4; ++b_) c2[b_] = CKEY(3, b_);
#pragma unroll
        for (int b_ = 0; b_ < 3; ++b_) c2[4 + b_] = CKEY(4, b_);
        c2[7] = CKEY(6, 0); c2[8] = CKEY(6, 1); c2[9] = CKEY(7, 0); c2[10] = CKEY(7, 1);
        c2[11] = CKEY(8, 0); c2[12] = CKEY(9, 0); c2[13] = CKEY(10, 0); c2[14] = CKEY(11, 0); c2[15] = CKEY(12, 0);
        c3[0] = CKEY(13, 0); c3[1] = CKEY(14, 0); c3[2] = CKEY(15, 0);
#pragma unroll
        for (int s = 3; s < 16; ++s) c3[s] = 0u;
#undef CKEY
        sort16_desc(ck); sort16_desc(c1); sort16_desc(c2); sort16_desc(c3);
        merge_top16(ck, c1); merge_top16(c2, c3); merge_top16(ck, c2);
        float vv[16]; int ex[16]; float mx = -3.0e38f;
#pragma unroll
        for (int s = 0; s < 16; ++s) { const int code = 255 - (int)(ck[s] & 255u), a_ = code >> 4, b_ = code & 15;
            vv[s] = r1[a_] + r2[b_]; ex[s] = __builtin_bit_cast(int, r1[16 + a_]) * 128 + __builtin_bit_cast(int, r2[16 + b_]); mx = fmaxf(mx, vv[s]); }
        float sm = 0.f;
#pragma unroll
        for (int s = 0; s < 16; ++s) { vv[s] = __expf(vv[s] - mx); sm += vv[s]; }
        const float inv = 1.0f / sm;
        unsigned short* ip = idxb + (size_t)(t0 + tid) * 128 + h * 16; float* gp = gateb + (size_t)(t0 + tid) * 128 + h * 16;
#pragma unroll
        for (int s8 = 0; s8 < 2; ++s8) *(v4u*)(ip + 8 * s8) = (v4u){(unsigned)ex[8 * s8] | ((unsigned)ex[8 * s8 + 1] << 16), (unsigned)ex[8 * s8 + 2] | ((unsigned)ex[8 * s8 + 3] << 16), (unsigned)ex[8 * s8 + 4] | ((unsigned)ex[8 * s8 + 5] << 16), (unsigned)ex[8 * s8 + 6] | ((unsigned)ex[8 * s8 + 7] << 16)};
#pragma unroll
        for (int s4 = 0; s4 < 4; ++s4) *(f32x4*)(gp + 4 * s4) = (f32x4){vv[4 * s4] * inv, vv[4 * s4 + 1] * inv, vv[4 * s4 + 2] * inv, vv[4 * s4 + 3] * inv};
    }
    __syncthreads();
}

__device__ __forceinline__ void mx_fold_unit(const Frame& F0, int l, int h, int mb, int cb) {
    PH_BEGIN; const Frame F = frame_local(F0);
    const int wid = F.wave, lane = F.lane, g = lane >> 4, l15 = lane & 15, wn = wid >> 2, wc = wid & 3;
    const bf16* km = WSP(bf16, WS_KMEM) + (size_t)(128 * mb + 64 * wn + l15) * 1024 + h * 256 + 8 * g;
    const float* wq = INP(I_WXQ) + (size_t)l * D * D + (size_t)(128 * cb + 32 * wc + l15) * D + h * 256 + 8 * g;
    float gxv[2];
#pragma unroll
    for (int n = 0; n < 2; ++n) gxv[n] = INP(I_GX)[l * D + 128 * cb + 32 * wc + 16 * n + l15];
    f32x4 acc[4][2];
#pragma unroll
    for (int m = 0; m < 4; ++m) { acc[m][0] = (f32x4){0.f, 0.f, 0.f, 0.f}; acc[m][1] = (f32x4){0.f, 0.f, 0.f, 0.f}; }
#pragma unroll 1
    for (int kg = 0; kg < 8; kg += 4) {
        bf16x8 av[4][4]; f32x4 wa[4][2], wb[4][2];
#pragma unroll
        for (int k4 = 0; k4 < 4; ++k4) {
#pragma unroll
            for (int m = 0; m < 4; ++m) av[k4][m] = *(const bf16x8*)(km + (size_t)m * 16 * 1024 + 32 * (kg + k4));
#pragma unroll
            for (int n = 0; n < 2; ++n) { const f32x4* p = (const f32x4*)(wq + (size_t)n * 16 * D + 32 * (kg + k4)); wa[k4][n] = p[0]; wb[k4][n] = p[1]; } }
#pragma unroll
        for (int k4 = 0; k4 < 4; ++k4) { KEEP4(av[k4][0], av[k4][1], av[k4][2], av[k4][3]); KEEP4(wa[k4][0], wa[k4][1], wb[k4][0], wb[k4][1]); }
#pragma unroll
        for (int k4 = 0; k4 < 4; ++k4) { bf16x8 bv[2];
#pragma unroll
            for (int n = 0; n < 2; ++n) { const f32x4 a = wa[k4][n], b = wb[k4][n]; v4u w; w.x = pk2(a.x, a.y); w.y = pk2(a.z, a.w); w.z = pk2(b.x, b.y); w.w = pk2(b.z, b.w); bv[n] = __builtin_bit_cast(bf16x8, w); }
#pragma unroll
            for (int m = 0; m < 4; ++m)
#pragma unroll
                for (int n = 0; n < 2; ++n) acc[m][n] = MFMA16(av[k4][m], bv[n], acc[m][n]); }
    }
    bf16* o = WSP(bf16, WS_WXQ) + (size_t)(h * 256 + 128 * mb) * 1024 + 128 * cb;
#pragma unroll
    for (int m = 0; m < 4; ++m)
#pragma unroll
        for (int n = 0; n < 2; ++n)
#pragma unroll
            for (int r = 0; r < 4; ++r) o[(size_t)(64 * wn + 16 * m + 4 * g + r) * 1024 + 32 * wc + 16 * n + l15] = (bf16)f2bf(acc[m][n][r] * gxv[n]);
}
__device__ __forceinline__ void vo_fold_unit(const Frame& F0, int h, int cb, int mb) {
    PH_BEGIN; const Frame F = frame_local(F0);
    const int wid = F.wave, lane = F.lane, g = lane >> 4, l15 = lane & 15, wn = wid >> 2, wc = wid & 3;
    const bf16* wo = WSP(bf16, WS_WXO) + (size_t)(128 * cb + 64 * wn + l15) * 1024 + h * 256 + 8 * g;
    const bf16* vm = WSP(bf16, WS_VMEMT) + (size_t)(128 * mb + 32 * wc + l15) * 1024 + h * 256 + 8 * g;
    f32x4 acc[4][2];
#pragma unroll
    for (int m = 0; m < 4; ++m) { acc[m][0] = (f32x4){0.f, 0.f, 0.f, 0.f}; acc[m][1] = (f32x4){0.f, 0.f, 0.f, 0.f}; }
#pragma unroll 1
    for (int kg = 0; kg < 8; kg += 4) {
        bf16x8 av[4][4], bv[4][2];
#pragma unroll
        for (int k4 = 0; k4 < 4; ++k4) {
#pragma unroll
            for (int m = 0; m < 4; ++m) av[k4][m] = *(const bf16x8*)(wo + (size_t)m * 16 * 1024 + 32 * (kg + k4));
#pragma unroll
            for (int n = 0; n < 2; ++n) bv[k4][n] = *(const bf16x8*)(vm + (size_t)n * 16 * 1024 + 32 * (kg + k4)); }
#pragma unroll
        for (int k4 = 0; k4 < 4; ++k4) { KEEP4(av[k4][0], av[k4][1], av[k4][2], av[k4][3]); KEEP2(bv[k4][0], bv[k4][1]); }
#pragma unroll
        for (int k4 = 0; k4 < 4; ++k4)
#pragma unroll
            for (int m = 0; m < 4; ++m)
#pragma unroll
                for (int n = 0; n < 2; ++n) acc[m][n] = MFMA16(av[k4][m], bv[k4][n], acc[m][n]);
    }
    bf16* o = WSP(bf16, WS_WXV) + (size_t)(128 * cb) * 1024 + h * 256 + 128 * mb;
#pragma unroll
    for (int m = 0; m < 4; ++m)
#pragma unroll
        for (int n = 0; n < 2; ++n)
#pragma unroll
            for (int r = 0; r < 4; ++r) o[(size_t)(64 * wn + 16 * m + 4 * g + r) * 1024 + 32 * wc + 16 * n + l15] = (bf16)f2bf(acc[m][n][r]);
}
__device__ __forceinline__ void memkv_block(const Frame& F0, int u) {
    PH_BEGIN; const Frame F = frame_local(F0);
    const int wid = F.wave, lane = F.lane, g = lane >> 4, l15 = lane & 15, wm = wid >> 1, wn = wid & 1;
    const int which = u >> 7, mb = (u >> 5) & 3, nb = u & 31;
    const bf16* ap = WSP(bf16, WS_MEMN) + (size_t)(64 * mb + 16 * wm + l15) * 1024 + 8 * g;
    const bf16* bp = WSP(bf16, which ? WS_WXV : WS_WXK) + (size_t)(32 * nb + 16 * wn + l15) * 1024 + 8 * g;
    f32x4 acc0 = {0.f, 0.f, 0.f, 0.f}, acc1 = {0.f, 0.f, 0.f, 0.f};
#pragma unroll 1
    for (int kb = 0; kb < 32; kb += 8) {
        bf16x8 av[8], bv[8];
#pragma unroll
        for (int j = 0; j < 8; ++j) { av[j] = *(const bf16x8*)(ap + 32 * (kb + j)); bv[j] = *(const bf16x8*)(bp + 32 * (kb + j)); }
        KEEP8(av); KEEP8(bv);
#pragma unroll
        for (int j = 0; j < 8; j += 2) { acc0 = MFMA16(av[j], bv[j], acc0); acc1 = MFMA16(av[j + 1], bv[j + 1], acc1); }
    }
    bf16* o = WSP(bf16, which ? WS_VMEMT : WS_KMEM) + (size_t)(64 * mb + 16 * wm + 4 * g) * 1024 + 32 * nb + 16 * wn + l15;
#pragma unroll
    for (int r = 0; r < 4; ++r) o[(size_t)r * 1024] = (bf16)f2bf(acc0[r] + acc1[r]);
}
struct EpiSoftmax {
    static constexpr bool PERM = true, AFTER_DRAIN = true;
    const ss_t* ss; bf16* P;
    __device__ __forceinline__ void fused(f32x4 (&acc)[2][2][4][2], const pg8::Unit& u, int wr, int wc, int fr, int fq, LAS unsigned char* ldsb, int wid, int lane) const {
        LAS float* RED = (LAS float*)ldsb;
        float mloc[2][4]; ss_t ssv[8];
#pragma unroll
        for (int i = 0; i < 8; ++i) ssv[i] = ss[u.pm * 256 + (i >> 2) * 128 + wr * 64 + (i & 3) * 16 + fr];
        KEEP8(ssv);
#pragma unroll
        for (int ai = 0; ai < 2; ++ai)
#pragma unroll
            for (int m = 0; m < 4; ++m) { const int row = ai * 128 + wr * 64 + m * 16 + fr;
                const float rsc = __builtin_amdgcn_rsqf(ss_flt(ssv[ai * 4 + m]) * (1.0f / 1024.0f) + EPS) * 0.09016844005556021f;
                float mx = -3.0e38f;
#pragma unroll
                for (int bj = 0; bj < 2; ++bj)
#pragma unroll
                    for (int n = 0; n < 2; ++n) { acc[ai][bj][m][n] = acc[ai][bj][m][n] * rsc; const f32x4 v = acc[ai][bj][m][n]; mx = fmaxf(fmaxf(mx, fmaxf(v[0], v[1])), fmaxf(v[2], v[3])); }
                mx = cross_row_max(mx);
                float sm = 0.f;
#pragma unroll
                for (int bj = 0; bj < 2; ++bj)
#pragma unroll
                    for (int n = 0; n < 2; ++n)
#pragma unroll
                        for (int j = 0; j < 4; ++j) { const float pv = __builtin_amdgcn_exp2f(acc[ai][bj][m][n][j] - mx); acc[ai][bj][m][n][j] = pv; sm += pv; }
                sm = cross_row_sum(sm);
                mloc[ai][m] = mx;
                if (fq == 0) { RED[(row * 4 + wc) * 2] = mx; RED[(row * 4 + wc) * 2 + 1] = sm; } }
        __syncthreads();
#pragma unroll
        for (int ai = 0; ai < 2; ++ai)
#pragma unroll
            for (int m = 0; m < 4; ++m) { const int row = ai * 128 + wr * 64 + m * 16 + fr;
                const f32x4 ra = *(const LAS f32x4*)(RED + row * 8), rb = *(const LAS f32x4*)(RED + row * 8 + 4);
                const float M = fmaxf(fmaxf(ra[0], ra[2]), fmaxf(rb[0], rb[2]));
                const float L = ra[1] * __builtin_amdgcn_exp2f(ra[0] - M) + ra[3] * __builtin_amdgcn_exp2f(ra[2] - M) + rb[1] * __builtin_amdgcn_exp2f(rb[0] - M) + rb[3] * __builtin_amdgcn_exp2f(rb[2] - M);
                const float f = __builtin_amdgcn_exp2f(mloc[ai][m] - M) * __builtin_amdgcn_rcpf(L);
                bf16* prow = P + (size_t)(u.pm * 256 + row) * 1024 + u.pn * 256 + wc * 32 + 8 * fq;
#pragma unroll
                for (int bj = 0; bj < 2; ++bj) { const f32x4 v0 = acc[ai][bj][m][0] * f, v1 = acc[ai][bj][m][1] * f; v4u w; w.x = pk2(v0[0], v0[1]); w.y = pk2(v0[2], v0[3]); w.z = pk2(v1[0], v1[1]); w.w = pk2(v1[2], v1[3]); *(v4u*)(prow + bj * 128) = w; } }
        __syncthreads();
    }
};
struct EpiTopk {
    static constexpr bool PERM = false, AFTER_DRAIN = true;
    const ss_t* ss; unsigned short* idx; float* gate; int head0;
    __device__ __forceinline__ void fused(f32x4 (&acc)[2][2][4][2], const pg8::Unit& u, int wr, int wc, int fr, int fq, LAS unsigned char* ldsb, int wid, int lane) const {
        LAS float* SC = (LAS float*)(ldsb + TK_SC);
        const int tid = wid * 64 + lane;
        ss_t ssv[2][4];
#pragma unroll
        for (int ai = 0; ai < 2; ++ai)
#pragma unroll
            for (int m = 0; m < 4; ++m) ssv[ai][m] = ss[u.pm * 256 + ai * 128 + wr * 64 + m * 16 + fr];
        KEEP4(ssv[0][0], ssv[0][1], ssv[0][2], ssv[0][3]); KEEP4(ssv[1][0], ssv[1][1], ssv[1][2], ssv[1][3]);
#pragma unroll
        for (int ai = 0; ai < 2; ++ai) {
            const int t0 = u.pm * 256 + ai * 128;
#pragma unroll
            for (int m = 0; m < 4; ++m) { const int row = wr * 64 + m * 16 + fr; const float rsc = __builtin_amdgcn_rsqf(ss_flt(ssv[ai][m]) * (1.0f / 1024.0f) + EPS);
#pragma unroll
                for (int bj = 0; bj < 2; ++bj)
#pragma unroll
                    for (int n = 0; n < 2; ++n) { const f32x4 v = acc[ai][bj][m][n] * rsc; LAS float* p = SC + (bj * 128 + row) * 129 + wc * 32 + n * 16 + 4 * fq;
                        p[0] = v[0]; p[1] = v[1]; p[2] = v[2]; p[3] = v[3]; } }
            __syncthreads();
            topk_select(ldsb, tid, t0, head0 + u.pn, idx, gate);
        }
    }
};
__device__ __forceinline__ void pq_fold_unit(const Frame& F0, int l, int hs, int cb) {
    PH_BEGIN; const Frame F = frame_local(F0);
    const int wid = F.wave, lane = F.lane, g = lane >> 4, l15 = lane & 15;
    const int wn = wid >> 2, wc = wid & 3, h = hs >> 1, side = hs & 1;
    const float* sk = INP(side ? I_SK2 : I_SK1) + (size_t)l * 8 * 128 * 128 + (size_t)h * 128 * 128;
    const float* wq = INP(I_WPQ) + (size_t)l * D * PQC + h * 256 + side * 128;
    float gfv[2];
#pragma unroll
    for (int n = 0; n < 2; ++n) gfv[n] = INP(I_GFFN)[l * D + 128 * cb + 32 * wc + 16 * n + l15];
    f32x4 acc[4][2];
#pragma unroll
    for (int m = 0; m < 4; ++m) { acc[m][0] = (f32x4){0.f, 0.f, 0.f, 0.f}; acc[m][1] = (f32x4){0.f, 0.f, 0.f, 0.f}; }
#pragma unroll 1
    for (int kg = 0; kg < 4; kg += 2) {
        f32x4 sa[2][4], sb[2][4], wa[2][2], wb[2][2];
#pragma unroll
        for (int k2 = 0; k2 < 2; ++k2) {
#pragma unroll
            for (int m = 0; m < 4; ++m) { const f32x4* p = (const f32x4*)(sk + (size_t)(64 * wn + 16 * m + l15) * 128 + 32 * (kg + k2) + 8 * g); sa[k2][m] = p[0]; sb[k2][m] = p[1]; }
#pragma unroll
            for (int n = 0; n < 2; ++n) { const f32x4* p = (const f32x4*)(wq + (size_t)(128 * cb + 32 * wc + 16 * n + l15) * PQC + 32 * (kg + k2) + 8 * g); wa[k2][n] = p[0]; wb[k2][n] = p[1]; } }
#pragma unroll
        for (int k2 = 0; k2 < 2; ++k2) { KEEP4(sa[k2][0], sa[k2][1], sa[k2][2], sa[k2][3]); KEEP4(sb[k2][0], sb[k2][1], sb[k2][2], sb[k2][3]); KEEP4(wa[k2][0], wa[k2][1], wb[k2][0], wb[k2][1]); }
#pragma unroll
        for (int k2 = 0; k2 < 2; ++k2) { bf16x8 av[4], bv[2];
#pragma unroll
            for (int m = 0; m < 4; ++m) { const f32x4 a = sa[k2][m], b = sb[k2][m]; v4u w; w.x = pk2(a.x, a.y); w.y = pk2(a.z, a.w); w.z = pk2(b.x, b.y); w.w = pk2(b.z, b.w); av[m] = __builtin_bit_cast(bf16x8, w); }
#pragma unroll
            for (int n = 0; n < 2; ++n) { const f32x4 a = wa[k2][n], b = wb[k2][n]; v4u w; w.x = pk2(a.x, a.y); w.y = pk2(a.z, a.w); w.z = pk2(b.x, b.y); w.w = pk2(b.z, b.w); bv[n] = __builtin_bit_cast(bf16x8, w); }
#pragma unroll
            for (int m = 0; m < 4; ++m)
#pragma unroll
                for (int n = 0; n < 2; ++n) acc[m][n] = MFMA16(av[m], bv[n], acc[m][n]); }
    }
    bf16* mt = WSP(bf16, WS_WPQ) + (size_t)hs * 128 * 1024;
#pragma unroll
    for (int m = 0; m < 4; ++m)
#pragma unroll
        for (int n = 0; n < 2; ++n)
#pragma unroll
            for (int r = 0; r < 4; ++r) mt[(size_t)(64 * wn + 16 * m + 4 * g + r) * 1024 + 128 * cb + 32 * wc + 16 * n + l15] = (bf16)f2bf(acc[m][n][r] * gfv[n]);
}
typedef float f32x2 __attribute__((ext_vector_type(2)));
template <int CTRL> __device__ __forceinline__ int dppi(int x) { return __builtin_amdgcn_mov_dpp(x, CTRL, 0xf, 0xf, true); }
typedef int pu_v4i_t __attribute__((ext_vector_type(4)));
typedef float pvf2_t __attribute__((ext_vector_type(2)));
#define PU_LOAD_R(t_, R) do { const v4u* ip_ = (const v4u*)(WSP(unsigned short, WS_IDX) + (size_t)(t_) * 128 + 16 * grp); _Pragma("unroll") for (int q_ = 0; q_ < 2; ++q_) { const v4u v_ = ip_[q_]; _Pragma("unroll") for (int j_ = 0; j_ < 4; ++j_) { R[8 * q_ + 2 * j_] = (int)(v_[j_] & 0xffffu); R[8 * q_ + 2 * j_ + 1] = (int)(v_[j_] >> 16); } } } while (0)
#define PU_ISSUE(t_, Q, R, HX) do { _Pragma("unroll") for (int b_ = 0; b_ < 16; ++b_) Q[b_] = *(const v4u*)(PUx + (size_t)(unsigned)((R[b_] << 7) + 16 * sub)); \
        const v4u* xr_ = (const v4u*)(WSP(bf16, WS_XN) + (size_t)(t_) * 1024 + 128 * x + 16 * sub); HX[0] = xr_[0]; HX[1] = xr_[1]; } while (0)
#define PU_COMPUTE(t_, Q, HX) do { float h_[16]; float am_ = 0.f; \
        _Pragma("unroll") for (int j_ = 0; j_ < 2; ++j_) _Pragma("unroll") for (int w_ = 0; w_ < 4; ++w_) { const unsigned u_ = HX[j_][w_]; h_[8 * j_ + 2 * w_] = bflo(u_); h_[8 * j_ + 2 * w_ + 1] = bfhi(u_); \
            am_ = fmaxf(am_, fmaxf(fabsf(h_[8 * j_ + 2 * w_]), fabsf(h_[8 * j_ + 2 * w_ + 1]))); } \
        am_ = fmaxf(am_, dppf<0xB1>(am_)); am_ = fmaxf(am_, dppf<0x4E>(am_)); am_ = fmaxf(am_, dppf<0x141>(am_));          \
        const float sc_ = am_ > 0.f ? 127.0f * __builtin_amdgcn_rcpf(am_) : 0.f, inv_ = am_ * (1.0f / 127.0f); \
        int hq_[4]; \
        _Pragma("unroll") for (int w_ = 0; w_ < 4; ++w_) hq_[w_] = (int)pack_i8x4(h_[4 * w_] * sc_, h_[4 * w_ + 1] * sc_, h_[4 * w_ + 2] * sc_, h_[4 * w_ + 3] * sc_); \
        int res_[16]; \
        _Pragma("unroll") for (int b_ = 0; b_ < 16; ++b_) { int a_ = 0; \
            _Pragma("unroll") for (int w_ = 0; w_ < 4; ++w_) { const unsigned qw_ = Q[b_][w_]; a_ = __builtin_amdgcn_sdot4((int)qw_, hq_[w_], a_, false); } \
            a_ += dppi<0xB1>(a_); a_ += dppi<0x4E>(a_); a_ += dppi<0x141>(a_); res_[b_] = a_; }                                   \
        int v0_ = res_[0], v1_ = res_[1]; \
        _Pragma("unroll") for (int s_ = 1; s_ < 8; ++s_) { v0_ = (sub == s_) ? res_[2 * s_] : v0_; v1_ = (sub == s_) ? res_[2 * s_ + 1] : v1_; } \
        sraw[(size_t)(t_) * 64 + lane] = pk2((float)v0_ * inv_, (float)v1_ * inv_); } while (0)
template <bool FAKE>
__device__ __forceinline__ void peer_u_phase(const Frame& F0) {
    PH_BEGIN; const Frame F = frame_local(F0);
    const int lane = F.lane, x = blockIdx.x & 7, grp = lane >> 3, sub = lane & 7;
    const int nwv = ((F.G - x + 7) >> 3) * NWAVES, wv = (blockIdx.x >> 3) * NWAVES + F.wave;
    const unsigned char* PUx = WSP(unsigned char, WS_PU8) + (size_t)x * SLICE_BYTES;
    unsigned* sraw = WSP(unsigned, WS_SRAW) + (size_t)x * T * 64;
    int ri[16]; v4u ha[2], hb[2]; v4u qa[16], qb[16];
    const int ntok = T / nwv;
    if (T % nwv == 0 && (ntok & 1) == 0 && wv < nwv) {
        const int tlast = wv + (ntok - 1) * nwv;
        PU_LOAD_R(wv, ri); PU_ISSUE(wv, qa, ri, ha); PU_LOAD_R(wv + nwv, ri);
#pragma unroll 1
        for (int t = wv; t <= tlast; t += 2 * nwv) {
            const int t2 = min(t + 2 * nwv, tlast), t3 = min(t + 3 * nwv, tlast);
            PU_ISSUE(t + nwv, qb, ri, hb); PU_LOAD_R(t2, ri); PU_COMPUTE(t, qa, ha);
            PU_ISSUE(t2, qa, ri, ha); PU_LOAD_R(t3, ri); PU_COMPUTE(t + nwv, qb, hb);
        }
    } else {
        for (int t = wv; t < T; t += nwv) { PU_LOAD_R(t, ri); PU_ISSUE(t, qa, ri, ha); PU_COMPUTE(t, qa, ha); }
    }
}
#undef PU_LOAD_R
#undef PU_ISSUE
#undef PU_COMPUTE
__device__ __forceinline__ void peer_combine(const Frame& F0) {
    PH_BEGIN; const Frame F = frame_local(F0);
    const size_t gt = (size_t)F.vcu * NTHR + F.tid, GN = (size_t)F.G * NTHR;
    for (size_t g8 = gt; g8 < (size_t)T * 16; g8 += GN) {
        v4u p[8]; f32x4 ga, gb;
        const v4u ixv = WSP(v4u, WS_IDX)[g8];
#pragma unroll
        for (int x = 0; x < 8; ++x) p[x] = WSP(v4u, WS_SRAW)[(size_t)x * T * 16 + g8];
        ss_t q = WSP(ss_t, WS_SSB)[g8 >> 4]; ga = WSP(f32x4, WS_GATE)[2 * g8]; gb = WSP(f32x4, WS_GATE)[2 * g8 + 1];
        v4u ixk = ixv; KEEP4(ixk.x, ixk.y, ixk.z, ixk.w);
        float uu[8], vv[8];
#pragma unroll
        for (int j = 0; j < 4; ++j) { const unsigned i0 = ixk[j] & 0xffffu, i1 = ixk[j] >> 16; uu[2 * j] = WSP(float, WS_SCU)[i0]; uu[2 * j + 1] = WSP(float, WS_SCU)[i1]; vv[2 * j] = WSP(float, WS_SCV)[i0]; vv[2 * j + 1] = WSP(float, WS_SCV)[i1]; }
        KEEP8(p); KEEP2(ga, gb); KEEP8(uu); KEEP8(vv);
        const float rs = __builtin_amdgcn_rsqf(ss_flt(q) * (1.0f / 1024.0f) + EPS);
        float w[8];
#pragma unroll
        for (int j = 0; j < 4; ++j) {
            const float s0 = ((bflo(p[0][j]) + bflo(p[1][j])) + (bflo(p[2][j]) + bflo(p[3][j]))) + ((bflo(p[4][j]) + bflo(p[5][j])) + (bflo(p[6][j]) + bflo(p[7][j])));
            const float s1 = ((bfhi(p[0][j]) + bfhi(p[1][j])) + (bfhi(p[2][j]) + bfhi(p[3][j]))) + ((bfhi(p[4][j]) + bfhi(p[5][j])) + (bfhi(p[6][j]) + bfhi(p[7][j])));
            const float g0 = (j < 2) ? ga[2 * j] : gb[2 * j - 4], g1 = (j < 2) ? ga[2 * j + 1] : gb[2 * j - 3];
            w[2 * j] = gelu_tanh(s0 * uu[2 * j] * rs) * g0 * vv[2 * j]; w[2 * j + 1] = gelu_tanh(s1 * uu[2 * j + 1] * rs) * g1 * vv[2 * j + 1]; }
        WSP(f32x4, WS_PW)[2 * g8] = (f32x4){w[0], w[1], w[2], w[3]}; WSP(f32x4, WS_PW)[2 * g8 + 1] = (f32x4){w[4], w[5], w[6], w[7]};
    }
}
#define PV_LOAD_R(t_, R) do { const v4u* ip_ = (const v4u*)(WSP(unsigned short, WS_IDX) + (size_t)(t_) * 128 + 16 * grp); _Pragma("unroll") for (int q_ = 0; q_ < 2; ++q_) { const v4u v_ = ip_[q_]; _Pragma("unroll") for (int j_ = 0; j_ < 4; ++j_) { R[8 * q_ + 2 * j_] = (int)(v_[j_] & 0xffffu); R[8 * q_ + 2 * j_ + 1] = (int)(v_[j_] >> 16); } } } while (0)
#define PV_ISSUE(t_, Q, R, WV, XR) do { const f32x4* wp_ = (const f32x4*)(WSP(float, WS_PW) + (size_t)(t_) * 128 + 16 * grp); _Pragma("unroll") for (int q_ = 0; q_ < 4; ++q_) { const f32x4 v_ = wp_[q_]; WV[4 * q_] = v_.x; WV[4 * q_ + 1] = v_.y; WV[4 * q_ + 2] = v_.z; WV[4 * q_ + 3] = v_.w; } \
        XR = *(const unsigned*)(WSP(bf16, WS_XN) + (size_t)(t_) * 1024 + 128 * x + 2 * cpair); \
        _Pragma("unroll") for (int b_ = 0; b_ < 16; ++b_) Q[b_] = *(const v4u*)(PVx + (size_t)(unsigned)((R[b_] << 7) + 16 * sub)); } while (0)
#define PV_COMPUTE(t_, Q, WV, XR) do { \
        pvf2_t ac_[8]; \
        _Pragma("unroll") for (int j_ = 0; j_ < 8; ++j_) ac_[j_] = (pvf2_t){0.f, 0.f}; \
        _Pragma("unroll") for (int b_ = 0; b_ < 16; ++b_) { const pvf2_t w2_ = {WV[b_], WV[b_]}; \
            _Pragma("unroll") for (int w_ = 0; w_ < 4; ++w_) { const int dw_ = (int)Q[b_][w_]; \
                ac_[2 * w_] = __builtin_elementwise_fma(__builtin_amdgcn_cvt_pk_f32_fp8(dw_, false), w2_, ac_[2 * w_]); \
                ac_[2 * w_ + 1] = __builtin_elementwise_fma(__builtin_amdgcn_cvt_pk_f32_fp8(dw_, true), w2_, ac_[2 * w_ + 1]); } } \
          \
          \
        pvf2_t k4_[4]; \
        _Pragma("unroll") for (int i_ = 0; i_ < 4; ++i_) { k4_[i_].x = half_sum32(ac_[i_].x, ac_[4 + i_].x); k4_[i_].y = half_sum32(ac_[i_].y, ac_[4 + i_].y); } \
        pvf2_t k2_[2]; \
        _Pragma("unroll") for (int i_ = 0; i_ < 2; ++i_) { k2_[i_].x = half_sum16(k4_[i_].x, k4_[2 + i_].x); k2_[i_].y = half_sum16(k4_[i_].y, k4_[2 + i_].y); } \
        pvf2_t o_; { const pvf2_t keep_ = b3 ? k2_[1] : k2_[0], send_ = b3 ? k2_[0] : k2_[1]; \
            o_.x = keep_.x + dppf<0x128>(send_.x); o_.y = keep_.y + dppf<0x128>(send_.y); } \
        const unsigned p_ = pk2(bflo(XR) + o_.x, bfhi(XR) + o_.y);                    \
        if (!DRYV || p_ == 0x12345678u) *(unsigned*)(WSP(bf16, WS_XN) + (size_t)(t_) * 1024 + 128 * x + 2 * cpair) = p_; \
        float ss_ = bflo(p_) * bflo(p_) + bfhi(p_) * bfhi(p_); \
        ss_ = wave_sum(ss_); \
        if (lane == 0 && (!DRYV || ss_ == 1.2345e30f)) atomicAdd(WSP(ss_t, WS_SSC) + (size_t)l * T + (t_), ss_fix(ss_)); } while (0)
__device__ __forceinline__ void peer_v_phase(const Frame& F0, int l, bool DRYV) {
    PH_BEGIN; const Frame F = frame_local(F0);
    const int lane = F.lane, x = blockIdx.x & 7, grp = lane >> 3, sub = lane & 7;
    const bool b3 = (lane & 8) != 0, b4 = (lane & 16) != 0, b5 = (lane & 32) != 0;
    const int cpair = 8 * sub + 4 * (int)b5 + 2 * (int)b4 + (int)b3;
    const int nwv = ((F.G - x + 7) >> 3) * NWAVES, wv = (blockIdx.x >> 3) * NWAVES + F.wave;
    const unsigned char* PVx = WSP(unsigned char, (l & 1) ? WS_PV8B : WS_PV8) + (size_t)x * SLICE_BYTES;
    int ri[16]; float wa[16], wb[16]; v4u qa[16], qb[16]; unsigned xa, xb;
    const int ntok = T / nwv;
    if (T % nwv == 0 && (ntok & 1) == 0 && wv < nwv) {
        const int tlast = wv + (ntok - 1) * nwv;
        PV_LOAD_R(wv, ri); PV_ISSUE(wv, qa, ri, wa, xa); PV_LOAD_R(wv + nwv, ri);
#pragma unroll 1
        for (int t = wv; t <= tlast; t += 2 * nwv) {
            const int t2 = min(t + 2 * nwv, tlast), t3 = min(t + 3 * nwv, tlast);
            PV_ISSUE(t + nwv, qb, ri, wb, xb); PV_LOAD_R(t2, ri); PV_COMPUTE(t, qa, wa, xa);
            PV_ISSUE(t2, qa, ri, wa, xa);
            PV_LOAD_R(t3, ri); PV_COMPUTE(t + nwv, qb, wb, xb);
        }
    } else {
        for (int t = wv; t < T; t += nwv) { PV_LOAD_R(t, ri); PV_ISSUE(t, qa, ri, wa, xa); PV_COMPUTE(t, qa, wa, xa); }
    }
}
#undef PV_LOAD_R
#undef PV_ISSUE
#undef PV_COMPUTE
__device__ __forceinline__ void final_norm(const Frame& F0) {
    PH_BEGIN; const Frame F = frame_local(F0);
    const size_t gt = (size_t)F.vcu * NTHR + F.tid, GN = (size_t)F.G * NTHR;
    const v2u* xs = WSP(v2u, WS_XN);
    if ((size_t)T * 256 % (4 * GN) == 0 && GN % 256 == 0) {
        const f32x4 gfin = ((const f32x4*)INP(I_GFIN))[gt & 255];
        v2u xv[4]; ss_t rs[4];
#pragma unroll
        for (int i = 0; i < 4; ++i) { xv[i] = xs[gt + i * GN]; rs[i] = WSP(ss_t, WS_SSC)[(size_t)T + ((gt + i * GN) >> 8)]; }
        for (size_t e = gt; e < (size_t)T * 256; e += 4 * GN) {
            const size_t en = (e + 4 * GN < (size_t)T * 256) ? e + 4 * GN : e;
            v2u xn[4]; ss_t rn[4];
#pragma unroll
            for (int i = 0; i < 4; ++i) { xn[i] = xs[en + i * GN]; rn[i] = WSP(ss_t, WS_SSC)[(size_t)T + ((en + i * GN) >> 8)]; }
            KEEP4(xv[0], xv[1], xv[2], xv[3]); KEEP4(rs[0], rs[1], rs[2], rs[3]);
#pragma unroll
            for (int i = 0; i < 4; ++i) { const f32x4 xf = {bflo(xv[i].x), bfhi(xv[i].x), bflo(xv[i].y), bfhi(xv[i].y)};
                ((f32x4*)X_)[e + i * GN] = xf * __builtin_amdgcn_rsqf(ss_flt(rs[i]) * (1.0f / 1024.0f) + EPS) * gfin; }
#pragma unroll
            for (int i = 0; i < 4; ++i) { xv[i] = xn[i]; rs[i] = rn[i]; }
        }
        return;
    }
    for (size_t e = gt; e < (size_t)T * 256; e += GN) { const int t = (int)(e >> 8), c4 = (int)(e & 255);
        const float rs = __builtin_amdgcn_rsqf(ss_flt(WSP(ss_t, WS_SSC)[(size_t)T + t]) * (1.0f / 1024.0f) + EPS);
        const v2u q = xs[e]; const f32x4 xf = {bflo(q.x), bfhi(q.x), bflo(q.y), bfhi(q.y)};
        ((f32x4*)X_)[e] = xf * rs * ((const f32x4*)INP(I_GFIN))[c4]; }
}

#ifndef MK_CODE
#define MK_CODE 0xFFFFFFFFu
#endif
#define CODE(b) ((MK_CODE >> (b)) & 1u)
#ifndef MK_PHASE_MASK
#define MK_PHASE_MASK 0xFFFFFFFFu
#endif
__global__ void __launch_bounds__(NWAVES * 64, 2) mk_fwd(Args args) {
    extern __shared__ __attribute__((aligned(16))) unsigned char lds[];
    Frame F;
    F.lds = (LAS unsigned char*)lds;
    F.tid = threadIdx.x; F.lane = F.tid & 63; F.wave = __builtin_amdgcn_readfirstlane(F.tid >> 6);
    F.G = gridDim.x; { const int bx = blockIdx.x; F.vcu = (F.G % 8 == 0) ? (bx % 8) * (F.G / 8) + bx / 8 : bx; }
    volatile LAS unsigned* MISC = (volatile LAS unsigned*)(F.lds + MISC_OFF);
    for (int u = F.tid; u < (LDS_BYTES - LDSCTL_OFF) / 4; u += NWAVES * 64) ((LAS unsigned*)(F.lds + LDSCTL_OFF))[u] = 0u;
    __syncthreads();
    XcdBarrier bar; { PH_BEGIN; bar = xcd_barrier_post((unsigned*)(ws_ + WS_CTL) + CW_BAR, MISC + 8);
        if (F.tid == 0) (void)__hip_atomic_fetch_or(&bar.bar[XB_XMASK(blockIdx.x & 7u)], 1u << bar.x, __ATOMIC_RELAXED, __HIP_MEMORY_SCOPE_AGENT); }
#ifndef REP_PRO
#define REP_PRO 1
#define REP_G1 1
#define REP_A 1
#define REP_FAKE 0
#define REP_LA 1
#define REP_R3 1
#define REP_LF 1
#define REP_M12 1
#define REP_XQ 1
#define REP_XA 1
#define REP_PQ 1
#define REP_TK 1
#define REP_GA 1
#define REP_NRM 1
#endif
#define GRID_BAR() xcd_barrier(bar)
#ifdef NO_RES_BAR
#define RES_BAR(k) xcd_barrier(bar)
#else
#define RES_BAR(k) res_barrier(bar, MISC + 10, (unsigned)(4 * l + (k)))
#endif
    const int G = F.G, bid = blockIdx.x;
    LAS unsigned char* ring = F.lds;

#ifdef TR8_TEST
    {
        PH_BEGIN; typedef int v2i_t __attribute__((ext_vector_type(2)));
        if (blockIdx.x == 0 && F.wave == 0) {
            LAS unsigned char* tt = F.lds;
            for (int i = F.lane; i < 64 * 144; i += 64) tt[i] = (unsigned char)((i / 144) * 16 + (i % 144));
            asm volatile("s_waitcnt lgkmcnt(0)" ::: "memory");
            const int g = F.lane >> 4, j = F.lane & 15;
            const v2i_t r = __builtin_amdgcn_ds_read_tr8_b64_v2i32((LAS v2i_t*)(tt + (8 * g + (j >> 1)) * 144 + 8 * (j & 1)));
            const unsigned r0 = (unsigned)r.x, r1 = (unsigned)r.y; int bad = 0;
            for (int e = 0; e < 8; ++e) { const unsigned got = ((e < 4 ? r0 : r1) >> (8 * (e & 3))) & 0xffu; const unsigned want = (unsigned)((8 * g + e) * 16 + j) & 0xffu; bad |= (got != want); }
            if (bad) ((unsigned*)(ws_ + WS_CTL))[2] = 1u;
        }
        __syncthreads();
    }
#endif
    if (CODE(0)) rotary_tables(F);
#pragma unroll 1
    for (int l = 0; l < NLAYER; ++l) {
        if (l == 0) { for (int rep = 0; rep < REP_PRO; ++rep) if (CODE(0)) { phase_prologue(F, l); for (int u = bid; u < 128; u += G) pq_fold_unit(F, l, u >> 3, u & 7); }
        GRID_BAR(); }
        if (l == 0 && F.tid == 0) {
            unsigned ok = (G % 8 == 0) ? 1u : 0u;
            for (unsigned j = 0; j < 8; ++j) { const unsigned m = xb_ld(&bar.bar[XB_XMASK(j)]); ok &= (__builtin_popcount(m) == 1) ? 1u : 0u; }
            MISC[10] = ok;
        }
        for (int rep = 0; rep < REP_G1; ++rep) if (CODE(1)) {
            PH_BEGIN; pg8::Gemm g{WSP(bf16, WS_XN), WSP(bf16, WS_WIN), T, INC, D}; pg8::StaticOrder S; S.init(T, INC, G, bid);
            pg8::EpiBf16<0> E{WSP(bf16, WS_Z), D, nullptr, D, (size_t)(ZSTRIDE / 2), 1.f, l == 0 ? (const ss_t*)WSP(ss_t, WS_SS0) : (const ss_t*)WSP(ss_t, WS_SSC)};
            pg8::gemm_phase<pg8::EpiBf16<0>, pg8::StaticOrder, PG8_ALIGN, PG8_SP2>(ring, g, S, E);
        }
        GRID_BAR();
        if (MK_PHASE_MASK & 1u) {
            const int swapA = (bid >> 3) & 1;
#pragma unroll 1
            for (int slot = 0; slot < 2; ++slot) {
                if ((slot ^ swapA) == 0) { for (int rep = 0; rep < REP_A; ++rep) if (CODE(3)) for (int u = bid; u < 512; u += G) r1_unit(F, u >> 2, u & 3); }
                else { for (int rep = 0; rep < REP_LA; ++rep) if (CODE(4)) for (int u = bid; u < 256; u += G) lru_strip_agg(F, l, u >> 3, u & 7); }
            }
        }
        GRID_BAR();
        if (MK_PHASE_MASK & 1u) { if (CODE(5)) r2_scan(F); if (CODE(6)) lru_carry(F); }
        if (CODE(2)) for (int u = bid; u < 256; u += G) memkv_block(F, u);
        GRID_BAR();
        if (MK_PHASE_MASK & 1u) {
            for (int rep = 1; rep < REP_R3; ++rep) if (CODE(7)) for (int u = bid; u < 512; u += G) r3_unit<true>(F, u >> 2, u & 3);
            const int swapC = (bid >> 3) & 1;
#pragma unroll 1
            for (int slot = 0; slot < 2; ++slot) {
                if ((slot ^ swapC) == 0) { if (CODE(7)) for (int u = bid; u < 512; u += G) r3_unit<false>(F, u >> 2, u & 3); }
                else { for (int rep = 0; rep < REP_LF; ++rep) if (CODE(8)) for (int u = bid; u < 256; u += G) lru_final(F, u >> 3, u & 7); }
            }
        }
        if (MK_PHASE_MASK & 2u) {
            for (int u = bid; u < 128; u += G) { if (u < 64) mx_fold_unit(F, l, u >> 4, (u >> 3) & 1, u & 7); else vo_fold_unit(F, (u - 64) >> 4, (u - 64) & 7, ((u - 64) >> 3) & 1); }
        }
        GRID_BAR();
        for (int rep = 0; rep < REP_M12; ++rep) if ((MK_PHASE_MASK & 1u) && CODE(9)) {
            {
                PH_BEGIN; pg8::Gemm g{WSP(bf16, WS_Z + 2 * ZSTRIDE), WSP(bf16, WS_WRET), T, D, D}; pg8::StaticOrder S; S.init(T, D, G, bid);
                pg8::EpiGateF32 E{WSP(bf16, WS_TMP), WSP(bf16, WS_Z + 5 * ZSTRIDE), D};
                pg8::gemm_phase<pg8::EpiGateF32, pg8::StaticOrder, PG8_ALIGN, PG8_SP2>(ring, g, S, E);
            }
            {
                PH_BEGIN; pg8::Gemm g{WSP(bf16, WS_Z + 4 * ZSTRIDE), WSP(bf16, WS_WRNN), T, D, D}; pg8::StaticOrder S; S.init(T, D, G, bid);
                pg8::EpiMergeBf16 E{WSP(bf16, WS_TMP), WSP(bf16, WS_Z + 6 * ZSTRIDE), WSP(bf16, WS_MERGED), D};
                pg8::gemm_phase<pg8::EpiMergeBf16, pg8::StaticOrder, PG8_ALIGN, PG8_SP2>(ring, g, S, E);
            }
        }
        RES_BAR(0);
        if ((MK_PHASE_MASK & 1u) && CODE(10)) {
            PH_BEGIN; pg8::Gemm g{WSP(bf16, WS_MERGED), WSP(bf16, WS_WMIX), T, D, D}; pg8::StaticOrder S; S.init(T, D, G, bid);
            pg8::EpiResid16 E{(const float*)nullptr, WSP(bf16, WS_XN), WSP(ss_t, WS_SSA), D};
            pg8::gemm_phase<pg8::EpiResid16, pg8::StaticOrder, PG8_ALIGN, PG8_SP2>(ring, g, S, E);
        }
        RES_BAR(1);
        if (MK_PHASE_MASK & 2u) {
            for (int rep = 0; rep < REP_XQ; ++rep) if (CODE(11)) {
                PH_BEGIN; pg8::Gemm g{WSP(bf16, WS_XN), WSP(bf16, WS_WXQ), T, D, D}; pg8::StaticOrder S; S.init(T, D, G, bid);
                EpiSoftmax E{WSP(ss_t, WS_SSA), WSP(bf16, WS_QX)};
                pg8::gemm_phase<EpiSoftmax, pg8::StaticOrder, false, PG8_SP2>(ring, g, S, E);
            }
            RES_BAR(2);
            if (CODE(13)) {
                PH_BEGIN; pg8::Gemm g{WSP(bf16, WS_QX), WSP(bf16, WS_WXV), T, D, D}; pg8::StaticOrder S; S.init(T, D, G, bid);
                pg8::EpiResid16 E{nullptr, WSP(bf16, WS_XN), WSP(ss_t, WS_SSB), D};
                pg8::gemm_phase<pg8::EpiResid16, pg8::StaticOrder, PG8_ALIGN, PG8_SP2>(ring, g, S, E);
            }
            RES_BAR(3);
        }
        if (MK_PHASE_MASK & 4u) {
            for (int rep = 0; rep < REP_PQ; ++rep) if (CODE(14)) {
#pragma unroll 1
                for (int half = 0; half < 2; ++half) {
                    PH_BEGIN; pg8::Gemm g{WSP(bf16, WS_XN), WSP(bf16, WS_WPQ) + (size_t)half * 1024 * 1024, T, D, D}; pg8::StaticOrder S; S.init(T, D, G, bid);
                    EpiTopk E{WSP(ss_t, WS_SSB), WSP(unsigned short, WS_IDX), WSP(float, WS_GATE), 4 * half};
                    pg8::gemm_phase<EpiTopk, pg8::StaticOrder, false, PG8_SP2>(ring, g, S, E);
                }
            }
            GRID_BAR();
#pragma unroll 1
            for (int rep = 0; rep < REP_GA; ++rep) if (CODE(16)) peer_u_phase<false>(F);
            GRID_BAR();
            if (CODE(16)) peer_combine(F);
            GRID_BAR();
#ifndef REP_V
#define REP_V 1
#endif
#pragma unroll 1
            for (int rep = 0; rep < REP_V; ++rep) if (CODE(16)) peer_v_phase(F, l, rep + 1 < REP_V);
            if (l + 1 < NLAYER && CODE(0)) { phase_prologue(F, l + 1); for (int u = bid; u < 128; u += G) pq_fold_unit(F, l + 1, u >> 3, u & 7); }
            GRID_BAR();
            if (l + 1 == NLAYER) final_norm(F);
#ifdef EXTRA_BARS
            if (l + 1 < NLAYER) for (int e_ = 0; e_ < EXTRA_BARS; ++e_) GRID_BAR();
#endif
        }
    }
}

extern "C" void kernel_launch(void* const* d_in, const int* in_sizes, int n_in, void* d_out, int out_size, void* d_ws, size_t ws_size, hipStream_t stream) {
    static int grid = 0;
    if (grid == 0) {
        if (n_in != 28 || in_sizes[0] != T * D || out_size != T * D || ws_size < WS_END) { fprintf(stderr, "kernel_launch: built for 28 inputs, x and out of %d floats, >= %zu bytes of workspace; got n_in %d, in0 %d, out %d, ws %zu; nothing launched\n", T * D, (size_t)WS_END, n_in, n_in > 0 ? in_sizes[0] : -1, out_size, ws_size); grid = -1; return; }
        int dev = 0, cus = 0, per_cu = 0;
        if (hipGetDevice(&dev) != hipSuccess || hipDeviceGetAttribute(&cus, hipDeviceAttributeMultiprocessorCount, dev) != hipSuccess) { fprintf(stderr, "kernel_launch: hipGetDevice / hipDeviceGetAttribute failed; nothing launched\n"); grid = -1; return; }
        if (hipFuncSetAttribute((const void*)mk_fwd, hipFuncAttributeMaxDynamicSharedMemorySize, LDS_BYTES) != hipSuccess) { fprintf(stderr, "kernel_launch: hipFuncSetAttribute failed (%d bytes of dynamic LDS); nothing launched\n", LDS_BYTES); grid = -1; return; }
        if (hipOccupancyMaxActiveBlocksPerMultiprocessor(&per_cu, (const void*)mk_fwd, NWAVES * 64, LDS_BYTES) != hipSuccess || per_cu < 1)
            fprintf(stderr, "kernel_launch: note: the occupancy query reports %d workgroups per CU\n", per_cu);
        (void)hipGetLastError();
        grid = cus;
    }
    if (grid < 0) return;
    if (hipMemsetAsync((char*)d_ws + WS_CTL, 0, CTL_ZERO_BYTES, stream) != hipSuccess) { fprintf(stderr, "kernel_launch: hipMemsetAsync of the control words failed; nothing launched\n"); return; }
    Args a{};
    for (int i = 0; i < 28; ++i) a.in[i] = (const float*)d_in[i];
    a.out = (float*)d_out; a.ws = (unsigned char*)d_ws;
    hipLaunchKernelGGL(mk_fwd, dim3(grid), dim3(NWAVES * 64), LDS_BYTES, stream, a);
    const hipError_t le = hipPeekAtLastError();
    if (le != hipSuccess) fprintf(stderr, "kernel_launch: launch failed: %s (grid %d x %d threads, %d B LDS)\n", hipGetErrorName(le), grid, NWAVES * 64, LDS_BYTES);
}
```
